# Optimizing an MI355X kernel written in HIP

```python
import math
import jax, jax.numpy as jnp
from jax import lax
import numpy as np

D_MODEL = 2048
BATCH = 4
SEQ = 2048
DEPTH = 2
DEC_BATCH = 128
DEC_SEQ = 8
PAST_LEN = 16384
PAGE_SIZE = 128

S5_WIDTH = D_MODEL // 2
S5_GROUP = 16
S5_GROUPS = S5_WIDTH // S5_GROUP
S5_STATE = 64
LRU_WIDTH = D_MODEL // 2
LRU_BLOCKS = 8
LRU_BLOCK = LRU_WIDTH // LRU_BLOCKS
CONV_WIDTH = 4
LRU_C = 8.0
RET_HEADS = 8
RET_DK = 128
RET_DV = 128
RET_WIDTH = RET_HEADS * RET_DV
RET_CHUNK = 128
ROPE_BASE = 10000.0
NORM_EPS = 1e-6
GN_EPS = 1e-5
IN_SIZES = (S5_WIDTH, S5_WIDTH, LRU_WIDTH, LRU_WIDTH, RET_HEADS * RET_DK, RET_HEADS * RET_DK,
            RET_WIDTH, RET_WIDTH, D_MODEL, D_MODEL, D_MODEL)
N_IN = sum(IN_SIZES)

kernel_name = 'hybrid_s5_rglru_retention_step'


def _rmsnorm(x, g):
    xf = x.astype(jnp.float32)
    y = xf * lax.rsqrt(jnp.mean(xf * xf, axis=-1, keepdims=True) + NORM_EPS)
    return (y * g.astype(jnp.float32)).astype(x.dtype)


def _combine(e1, e2):
    a1, b1 = e1
    a2, b2 = e2
    return a1 * a2, a2 * b1 + b2


def _s5(u, h0_re, h0_im, lam_re, lam_im, log_dt, b_re, b_im, c_re, c_im, d, w_glu, b_glu):
    bsz, s = u.shape[0], u.shape[1]
    ug = u.reshape(bsz, s, S5_GROUPS, S5_GROUP)
    lam = lax.complex(lam_re.astype(jnp.float32), lam_im.astype(jnp.float32))
    dt = jnp.exp(log_dt.astype(jnp.float32))[:, None]
    lam_bar = jnp.exp(lam * dt)
    b = lax.complex(b_re.astype(jnp.float32), b_im.astype(jnp.float32))
    b_bar = ((lam_bar - 1.0) / lam)[..., None] * b
    bu = jnp.einsum('bsgc,gpc->bsgp', ug.astype(jnp.complex64), b_bar)
    h0 = lax.complex(h0_re.astype(jnp.float32), h0_im.astype(jnp.float32))
    bu = bu.at[:, 0].add(lam_bar * h0)
    a = jnp.broadcast_to(lam_bar, bu.shape)
    _, h = lax.associative_scan(_combine, (a, bu), axis=1)
    y = (jnp.einsum('bsgp,gcp->bsgc', h.real, c_re.astype(jnp.float32))
         - jnp.einsum('bsgp,gcp->bsgc', h.imag, c_im.astype(jnp.float32))
         + d.astype(jnp.float32).reshape(S5_GROUPS, S5_GROUP) * ug)
    y = jax.nn.gelu(y.reshape(bsz, s, S5_WIDTH))
    y = y * jax.nn.sigmoid(y @ w_glu.astype(jnp.float32) + b_glu.astype(jnp.float32))
    h_last = h[:, -1]
    return y, h_last.real, h_last.imag


def _rglru(u, h0, conv_buf, conv_w, conv_b, w_a, b_a, w_x, b_x, lam):
    bsz, s = u.shape[0], u.shape[1]
    xp = jnp.concatenate([conv_buf.astype(jnp.float32), u], axis=1)
    cw = conv_w.astype(jnp.float32)
    xc = sum(xp[:, k:k + s] * cw[k] for k in range(CONV_WIDTH)) + conv_b.astype(jnp.float32)
    new_buf = xp[:, -(CONV_WIDTH - 1):]
    xb = xc.reshape(bsz, s, LRU_BLOCKS, LRU_BLOCK)
    r = jax.nn.sigmoid(jnp.einsum('bsnc,ncd->bsnd', xb, w_a.astype(jnp.float32)).reshape(bsz, s, LRU_WIDTH)
                       + b_a.astype(jnp.float32))
    i = jax.nn.sigmoid(jnp.einsum('bsnc,ncd->bsnd', xb, w_x.astype(jnp.float32)).reshape(bsz, s, LRU_WIDTH)
                       + b_x.astype(jnp.float32))
    log_a = -LRU_C * r * jax.nn.softplus(-lam.astype(jnp.float32))
    a = jnp.exp(log_a)
    bx = jnp.sqrt(-jnp.expm1(2.0 * log_a)) * (i * xc)
    bx = bx.at[:, 0].add(a[:, 0] * h0.astype(jnp.float32))
    _, h = lax.associative_scan(_combine, (a, bx), axis=1)
    return h, h[:, -1], new_buf


def _rope(t, pos):
    half = t.shape[-1] // 2
    freq = ROPE_BASE ** (-jnp.arange(half, dtype=jnp.float32) / half)
    ang = pos[:, None] * freq[None, :]
    cos = jnp.cos(ang)[None, :, None, :]
    sin = jnp.sin(ang)[None, :, None, :]
    t1, t2 = t[..., :half], t[..., half:]
    return jnp.concatenate([t1 * cos - t2 * sin, t1 * sin + t2 * cos], axis=-1)


def _retention(q, k, v, r0, pos0, gn_g):
    bsz, s = q.shape[0], q.shape[1]
    pos = jnp.arange(s, dtype=jnp.float32) + float(pos0)
    q = _rope(q.reshape(bsz, s, RET_HEADS, RET_DK), pos)
    k = _rope(k.reshape(bsz, s, RET_HEADS, RET_DK), pos) * (RET_DK ** -0.5)
    v = v.reshape(bsz, s, RET_HEADS, RET_DV)
    c = math.gcd(s, RET_CHUNK)
    nc = s // c
    log_g = jnp.log1p(-jnp.exp2(-5.0 - jnp.arange(RET_HEADS, dtype=jnp.float32)))
    idx = jnp.arange(c, dtype=jnp.float32)
    diff = idx[:, None] - idx[None, :]
    dmask = jnp.where(diff[None] >= 0, jnp.exp(jnp.maximum(diff, 0.0)[None] * log_g[:, None, None]), 0.0)
    xi = jnp.exp((idx[:, None] + 1.0) * log_g[None, :])
    zeta = jnp.exp((c - 1.0 - idx[:, None]) * log_g[None, :])
    g_chunk = jnp.exp(c * log_g)[None, :, None, None]

    def to_chunks(t):
        return jnp.moveaxis(t.reshape(bsz, nc, c, RET_HEADS, t.shape[-1]), 1, 0)

    def step(r, inp):
        qc, kc, vc = inp
        sc = jnp.einsum('bihd,bjhd->bhij', qc, kc) * dmask[None]
        inner = jnp.einsum('bhij,bjhe->bihe', sc, vc)
        cross = jnp.einsum('bihd,bhde->bihe', qc, r) * xi[None, :, :, None]
        r_new = r * g_chunk + jnp.einsum('bjhd,bjhe->bhde', kc * zeta[None, :, :, None], vc)
        return r_new, inner + cross

    r_last, o = lax.scan(step, r0.astype(jnp.float32), (to_chunks(q), to_chunks(k), to_chunks(v)))
    o = jnp.moveaxis(o, 0, 1).reshape(bsz, s, RET_HEADS, RET_DV)
    mu = jnp.mean(o, axis=-1, keepdims=True)
    var = jnp.mean(jnp.square(o - mu), axis=-1, keepdims=True)
    o = ((o - mu) * lax.rsqrt(var + GN_EPS)).reshape(bsz, s, RET_WIDTH) * gn_g.astype(jnp.float32)
    return o, r_last


def _layer(x, pos0, h_s5_re, h_s5_im, h_lru, conv_buf, r_ret, lp):
    xn = _rmsnorm(x, lp['norm_g'])
    proj = (xn @ lp['w_in']).astype(jnp.float32)
    splits = np.cumsum(IN_SIZES)[:-1].tolist()
    u_s5, z_s5, u_lru, z_lru, q, k, v, z_ret, g_s5, g_lru, g_ret = jnp.split(proj, splits, axis=-1)
    y_s5, ns_re, ns_im = _s5(u_s5, h_s5_re, h_s5_im, lp['s5_lambda_re'], lp['s5_lambda_im'], lp['s5_log_dt'],
                             lp['s5_b_re'], lp['s5_b_im'], lp['s5_c_re'], lp['s5_c_im'], lp['s5_d'],
                             lp['s5_w_glu'], lp['s5_b_glu'])
    y_lru, n_lru, n_conv = _rglru(u_lru, h_lru, conv_buf, lp['lru_conv_w'], lp['lru_conv_b'], lp['lru_w_a'],
                                  lp['lru_b_a'], lp['lru_w_x'], lp['lru_b_x'], lp['lru_lambda'])
    y_ret, n_ret = _retention(q, k, v, r_ret, pos0, lp['ret_gn_g'])
    b_s5 = (y_s5 * jax.nn.silu(z_s5)) @ lp['w_branch_s5'].astype(jnp.float32)
    b_lru = (y_lru * jax.nn.silu(z_lru)) @ lp['w_branch_lru'].astype(jnp.float32)
    b_ret = (y_ret * jax.nn.silu(z_ret)) @ lp['w_branch_ret'].astype(jnp.float32)
    merged = jax.nn.sigmoid(g_s5) * b_s5 + jax.nn.sigmoid(g_lru) * b_lru + jax.nn.sigmoid(g_ret) * b_ret
    out = merged @ lp['w_out'].astype(jnp.float32)
    return (x + out.astype(x.dtype)), ns_re, ns_im, n_lru, n_conv, n_ret


def setup_inputs(seed: int = 0) -> dict:
    key = jax.random.key(seed)
    it = iter(jax.random.split(key, 48))
    nrm = lambda shape, scale: jax.random.normal(next(it), shape, jnp.float32) * scale
    L = DEPTH
    inp = {}
    inp['x_prompt'] = nrm((BATCH, SEQ, D_MODEL), 1.0)
    inp['x_sample'] = nrm((DEC_BATCH, DEC_SEQ, D_MODEL), 1.0)
    inp['state_s5_re'] = nrm((L, DEC_BATCH, S5_GROUPS, S5_STATE), 0.3)
    inp['state_s5_im'] = nrm((L, DEC_BATCH, S5_GROUPS, S5_STATE), 0.3)
    inp['state_lru'] = nrm((L, DEC_BATCH, LRU_WIDTH), 0.5)
    inp['state_conv'] = nrm((L, DEC_BATCH, CONV_WIDTH - 1, LRU_WIDTH), 1.0)
    inp['state_ret'] = nrm((L, DEC_BATCH, RET_HEADS, RET_DK, RET_DV), 0.3)
    inp['norm_g'] = 1.0 + nrm((L, D_MODEL), 0.02)
    inp['w_in'] = nrm((L, D_MODEL, N_IN), D_MODEL ** -0.5)
    inp['s5_lambda_re'] = -0.5 + nrm((L, S5_GROUPS, S5_STATE), 0.01)
    inp['s5_lambda_im'] = (jnp.pi * jnp.arange(S5_STATE, dtype=jnp.float32))[None, None, :] + nrm((L, S5_GROUPS, S5_STATE), 0.01)
    inp['s5_log_dt'] = jax.random.uniform(next(it), (L, S5_GROUPS), jnp.float32, math.log(1e-3), math.log(1e-1))
    inp['s5_b_re'] = nrm((L, S5_GROUPS, S5_STATE, S5_GROUP), (2 * S5_GROUP) ** -0.5)
    inp['s5_b_im'] = nrm((L, S5_GROUPS, S5_STATE, S5_GROUP), (2 * S5_GROUP) ** -0.5)
    inp['s5_c_re'] = nrm((L, S5_GROUPS, S5_GROUP, S5_STATE), S5_STATE ** -0.5)
    inp['s5_c_im'] = nrm((L, S5_GROUPS, S5_GROUP, S5_STATE), S5_STATE ** -0.5)
    inp['s5_d'] = nrm((L, S5_WIDTH), 1.0)
    inp['s5_w_glu'] = nrm((L, S5_WIDTH, S5_WIDTH), S5_WIDTH ** -0.5)
    inp['s5_b_glu'] = nrm((L, S5_WIDTH), 0.01)
    inp['lru_conv_w'] = nrm((L, CONV_WIDTH, LRU_WIDTH), CONV_WIDTH ** -0.5)
    inp['lru_conv_b'] = nrm((L, LRU_WIDTH), 0.01)
    inp['lru_w_a'] = nrm((L, LRU_BLOCKS, LRU_BLOCK, LRU_BLOCK), LRU_BLOCK ** -0.5)
    inp['lru_b_a'] = nrm((L, LRU_WIDTH), 0.01)
    inp['lru_w_x'] = nrm((L, LRU_BLOCKS, LRU_BLOCK, LRU_BLOCK), LRU_BLOCK ** -0.5)
    inp['lru_b_x'] = nrm((L, LRU_WIDTH), 0.01)
    a8 = jax.random.uniform(next(it), (L, LRU_WIDTH), jnp.float32, 0.9, 0.999)
    a_base = a8 ** (1.0 / LRU_C)
    inp['lru_lambda'] = jnp.log(a_base) - jnp.log1p(-a_base)
    inp['ret_gn_g'] = 1.0 + nrm((L, RET_WIDTH), 0.02)
    inp['w_branch_s5'] = nrm((L, S5_WIDTH, D_MODEL), S5_WIDTH ** -0.5)
    inp['w_branch_lru'] = nrm((L, LRU_WIDTH, D_MODEL), LRU_WIDTH ** -0.5)
    inp['w_branch_ret'] = nrm((L, RET_WIDTH, D_MODEL), RET_WIDTH ** -0.5)
    inp['w_out'] = nrm((L, D_MODEL, D_MODEL), D_MODEL ** -0.5)
    inp['final_norm_g'] = 1.0 + nrm((D_MODEL,), 0.02)
    return inp


def reference(x_prompt, x_sample, state_s5_re, state_s5_im, state_lru, state_conv, state_ret,
              norm_g, w_in, s5_lambda_re, s5_lambda_im, s5_log_dt, s5_b_re, s5_b_im, s5_c_re, s5_c_im,
              s5_d, s5_w_glu, s5_b_glu, lru_conv_w, lru_conv_b, lru_w_a, lru_b_a, lru_w_x, lru_b_x,
              lru_lambda, ret_gn_g, w_branch_s5, w_branch_lru, w_branch_ret, w_out, final_norm_g):
    f32 = jnp.float32
    bp = x_prompt.shape[0]
    xp, xs = x_prompt, x_sample
    new_p = [[] for _ in range(5)]
    new_s = [[] for _ in range(5)]
    for l in range(DEPTH):
        lp = dict(norm_g=norm_g[l], w_in=w_in[l], s5_lambda_re=s5_lambda_re[l], s5_lambda_im=s5_lambda_im[l],
                  s5_log_dt=s5_log_dt[l], s5_b_re=s5_b_re[l], s5_b_im=s5_b_im[l], s5_c_re=s5_c_re[l],
                  s5_c_im=s5_c_im[l], s5_d=s5_d[l], s5_w_glu=s5_w_glu[l], s5_b_glu=s5_b_glu[l],
                  lru_conv_w=lru_conv_w[l], lru_conv_b=lru_conv_b[l], lru_w_a=lru_w_a[l], lru_b_a=lru_b_a[l],
                  lru_w_x=lru_w_x[l], lru_b_x=lru_b_x[l], lru_lambda=lru_lambda[l], ret_gn_g=ret_gn_g[l],
                  w_branch_s5=w_branch_s5[l], w_branch_lru=w_branch_lru[l], w_branch_ret=w_branch_ret[l],
                  w_out=w_out[l])
        xp, *sp = _layer(xp, 0,
                         jnp.zeros((bp, S5_GROUPS, S5_STATE), f32), jnp.zeros((bp, S5_GROUPS, S5_STATE), f32),
                         jnp.zeros((bp, LRU_WIDTH), f32), jnp.zeros((bp, CONV_WIDTH - 1, LRU_WIDTH), f32),
                         jnp.zeros((bp, RET_HEADS, RET_DK, RET_DV), f32), lp)
        xs, *ss = _layer(xs, PAST_LEN, state_s5_re[l], state_s5_im[l], state_lru[l], state_conv[l],
                         state_ret[l], lp)
        for j in range(5):
            new_p[j].append(sp[j])
            new_s[j].append(ss[j])
    y_prompt = _rmsnorm(xp, final_norm_g)
    y_sample = _rmsnorm(xs, final_norm_g)
    s5_re_p, s5_im_p, lru_p, conv_p, ret_p = [jnp.stack(t, axis=0) for t in new_p]
    s5_re_s, s5_im_s, lru_s, conv_s, ret_s = [jnp.stack(t, axis=0) for t in new_s]
    return (y_prompt, y_sample, s5_re_p, s5_im_p, lru_p, conv_p, ret_p, s5_re_s, s5_im_s, lru_s, conv_s, ret_s)
```

```cpp
#include <hip/hip_runtime.h>
#include <hip/hip_cooperative_groups.h>
#include <cstdio>
#include <cstdint>
namespace cg = cooperative_groups;

#ifndef PHMASK
#define PHMASK 0xFFFF
#endif
#ifndef MK_N_LAUNCHES
#define MK_N_LAUNCHES 1
#endif

#define LAS __attribute__((address_space(3)))
#define GAS __attribute__((address_space(1)))
typedef unsigned short bf16_t;
typedef short bf16x8 __attribute__((ext_vector_type(8)));
typedef float f32x4 __attribute__((ext_vector_type(4)));
typedef float f32x2 __attribute__((ext_vector_type(2)));
typedef unsigned u32x4 __attribute__((ext_vector_type(4)));
typedef unsigned u32x2 __attribute__((ext_vector_type(2)));

constexpr int DM = 2048, NB = 4, SEQ = 2048, DEPTH = 2, DB = 128, DS = 8, PAST = 16384;
constexpr int MP = NB * SEQ, MS = DB * DS, M = MP + MS;
constexpr int NIN = 14336;
constexpr int C_US5 = 0, C_ZS5 = 1024, C_ULRU = 2048, C_ZLRU = 3072, C_Q = 4096, C_K = 5120, C_V = 6144, C_ZRET = 7168, C_G = 8192;
constexpr int NH = 8, DK = 128, DV = 128, RC = 128, NCH = SEQ / RC;
constexpr int S5G = 64, S5P = 64, S5C = 16;
constexpr int S5L = 64, S5NCH = SEQ / S5L;
constexpr int LT = 64, LNT = SEQ / LT;
constexpr float NORM_EPS = 1e-6f, GN_EPS = 1e-5f;

constexpr size_t O_YP = 0, O_YS = 16777216, O_S5RP = 18874368, O_S5IP = 18907136, O_LRUP = 18939904, O_CONVP = 18948096, O_RETP = 18972672,
                 O_S5RS = 20021248, O_S5IS = 21069824, O_LRUS = 22118400, O_CONVS = 22380544, O_RETS = 23166976, O_END = 56721408;
constexpr size_t O_XB = O_RETS + 16777216;

constexpr size_t MiB = 1u << 20;
constexpr size_t WS_CTL = 0, CTL_ZERO_BYTES = 1 * MiB;
constexpr size_t WS_WIN = 1 * MiB, WS_WGLU = 57 * MiB, WS_WBR = 59 * MiB, WS_WOUT = 71 * MiB, WS_MERGED = 79 * MiB, WS_PROJ = 115 * MiB,
                 WS_YS5 = 367 * MiB, WS_AS5 = 385 * MiB, WS_ALRU = 403 * MiB, WS_ARET = 421 * MiB, WS_KV = 439 * MiB, WS_S5E = 471 * MiB, WS_S5HIN = 475 * MiB,
                 WS_MISC = 479 * MiB, WS_END = 487 * MiB;
static_assert(WS_ALRU - WS_AS5 == WS_ARET - WS_ALRU, "branch operands equally spaced");
constexpr size_t WS_LRUP = WS_AS5;
constexpr size_t MI_RS = 0;
constexpr size_t MI_RSP = 64 * 1024;
constexpr size_t MI_S5LB = MI_RSP + (size_t)M * 32 * 4;
constexpr size_t MI_S5BB = MI_S5LB + 4 * 4096 * 4;
constexpr size_t MI_ROPE = MI_S5BB + 2 * 65536 * 4;
constexpr size_t MI_LSUM = MI_ROPE + 2 * 2056 * 64 * 4;
constexpr size_t MI_LHIN = MI_LSUM + (size_t)NB * LNT * 1024 * 2 * 4;
constexpr size_t MI_END = MI_LHIN + (size_t)NB * LNT * 1024 * 4;
static_assert(MI_END <= 8 * MiB, "misc region");

__device__ __forceinline__ float bf2f(unsigned b) { return __uint_as_float(b << 16); }
__device__ __forceinline__ unsigned f2bf(float f) { unsigned u = __float_as_uint(f); return (u + 0x7fffu + ((u >> 16) & 1u)) >> 16; }
__device__ __forceinline__ unsigned pk2(float lo, float hi) { return f2bf(lo) | (f2bf(hi) << 16); }
__device__ __forceinline__ float bflo(unsigned w) { return __uint_as_float(w << 16); }
__device__ __forceinline__ float bfhi(unsigned w) { return __uint_as_float(w & 0xffff0000u); }
__device__ __forceinline__ float sigmoidf_(float x) { return 1.0f / (1.0f + __expf(-x)); }
__device__ __forceinline__ float siluf_(float x) { return x / (1.0f + __expf(-x)); }
__device__ __forceinline__ float gelu_tanh(float x) { const float u = 1.5957691216f * (x + 0.044715f * x * x * x); return x / (1.0f + __expf(-u)); }
__device__ __forceinline__ float wave_sum(float v) {
#pragma unroll
    for (int o = 1; o < 64; o <<= 1) v += __shfl_xor(v, o);
    return v;
}
#define LDS_WAIT() asm volatile("s_waitcnt lgkmcnt(0)" ::: "memory")
#define VM_WAIT() asm volatile("s_waitcnt vmcnt(0)" ::: "memory")

namespace pg8 {
constexpr int BM = 256, BK = 64, HALF = 128, HTB = HALF * BK * 2, STAGE_BYTES = 8 * HTB, NXCD = 8, WGM = 8;
__host__ __device__ __forceinline__ int lds_byte(int r, int c) { const int st = (r >> 4) * 2 + (c >> 5), rr = r & 15, cc = c & 31, ob = rr * 64 + cc * 2; return st * 1024 + (ob ^ (((ob >> 9) & 1) << 5)); }
__host__ __device__ __forceinline__ void stage_rc(int b, int& R, int& C) { const int st = b / 1024, sb = b % 1024, swz = sb ^ (((sb >> 9) & 1) << 5); R = (st >> 1) * 16 + swz / 64; C = (st & 1) * 32 + (swz % 64) / 2; }
__host__ __device__ __forceinline__ int perm32(int rho) { const int n = rho >> 4, i = rho & 15; return 8 * (i >> 2) + 4 * n + (i & 3); }

struct Unit { int pm, pn, z; };
struct Gemm { const bf16_t* A; const bf16_t* Bt; size_t zA, zB; int K; };
template <int NZ> __device__ __forceinline__ const char* selA(const Gemm& g, int z) { if (NZ == 1) return (const char*)g.A; return (const char*)g.A + (size_t)z * g.zA; }
template <int NZ> __device__ __forceinline__ const char* selB(const Gemm& g, int z) { if (NZ == 1) return (const char*)g.Bt; return (const char*)g.Bt + (size_t)z * g.zB; }

template <int NZ> struct StaticOrder {
    int nM, nN, nwg, G, c;
    __device__ void init(int M_, int N_, int G_, int c_) { nM = M_ / BM; nN = N_ / BM; nwg = nM * nN; G = G_; c = c_; }
    __device__ bool next(int i, Unit& u) const {
        const int it = (NZ == 1) ? i : i / NZ; u.z = (NZ == 1) ? 0 : i - it * NZ;
        const long L = (long)it * G + c; if (L >= nwg) return false;
        int wgid = (int)L; { const int q = nwg / NXCD, r = nwg % NXCD, xcd = wgid % NXCD, off = wgid / NXCD; wgid = (xcd < r ? xcd * (q + 1) : r * (q + 1) + (xcd - r) * q) + off; }
        const int nig = WGM * nN, gid = wgid / nig, fm = gid * WGM, gsz = (nM - fm) < WGM ? (nM - fm) : WGM;
        u.pm = fm + ((wgid % nig) % gsz); u.pn = (wgid % nig) / gsz; return true;
    }
};

__device__ __forceinline__ unsigned cvt_pk_bf16(float lo, float hi) { unsigned r; asm volatile("v_cvt_pk_bf16_f32 %0, %1, %2" : "=v"(r) : "v"(lo), "v"(hi)); return r; }


struct EpiProj {
    static constexpr bool PERM = true;
    bf16_t* O; const float* rs;
    __device__ __forceinline__ void operator()(const f32x4 (&acc)[2][2][4][2], const Unit& u, int wr, int wc, int fr, int fq) const {
        const int row0 = u.pm * BM + wr * 64 + fr, col0 = u.pn * BM + wc * 32 + 8 * fq;
#pragma unroll
        for (int ai = 0; ai < 2; ++ai)
#pragma unroll
            for (int m = 0; m < 4; ++m) { const int row = row0 + ai * HALF + m * 16; const float s = rs[row]; bf16_t* rowp = O + (size_t)row * NIN + col0;
#pragma unroll
                for (int bj = 0; bj < 2; ++bj) { const f32x4 v0 = acc[ai][bj][m][0] * s, v1 = acc[ai][bj][m][1] * s;
                    u32x4 w; w.x = cvt_pk_bf16(v0[0], v0[1]); w.y = cvt_pk_bf16(v0[2], v0[3]); w.z = cvt_pk_bf16(v1[0], v1[1]); w.w = cvt_pk_bf16(v1[2], v1[3]);
                    *(u32x4*)(rowp + bj * HALF) = w; } }
    }
};
struct EpiGlu {
    static constexpr bool PERM = true;
    bf16_t* O; const bf16_t* Y; const bf16_t* proj; const float* bias;
    __device__ __forceinline__ void operator()(const f32x4 (&acc)[2][2][4][2], const Unit& u, int wr, int wc, int fr, int fq) const {
        const int row0 = u.pm * BM + wr * 64 + fr, col0 = u.pn * BM + wc * 32 + 8 * fq;
#pragma unroll
        for (int bj = 0; bj < 2; ++bj) { const int col = col0 + bj * HALF; const f32x4 b0 = *(const f32x4*)(bias + col), b1 = *(const f32x4*)(bias + col + 4);
#pragma unroll
            for (int ai = 0; ai < 2; ++ai)
#pragma unroll
                for (int m = 0; m < 4; ++m) { const int row = row0 + ai * HALF + m * 16;
                    const u32x4 yv = *(const u32x4*)(Y + (size_t)row * 1024 + col), zv = *(const u32x4*)(proj + (size_t)row * NIN + C_ZS5 + col);
                    const f32x4 a0 = acc[ai][bj][m][0] + b0, a1 = acc[ai][bj][m][1] + b1; float o[8]; const float av[8] = {a0[0], a0[1], a0[2], a0[3], a1[0], a1[1], a1[2], a1[3]};
#pragma unroll
                    for (int j = 0; j < 4; ++j) { const unsigned yw = yv[j], zw = zv[j];
                        o[2 * j] = bflo(yw) * sigmoidf_(av[2 * j]) * siluf_(bflo(zw)); o[2 * j + 1] = bfhi(yw) * sigmoidf_(av[2 * j + 1]) * siluf_(bfhi(zw)); }
                    u32x4 w; w.x = cvt_pk_bf16(o[0], o[1]); w.y = cvt_pk_bf16(o[2], o[3]); w.z = cvt_pk_bf16(o[4], o[5]); w.w = cvt_pk_bf16(o[6], o[7]);
                    *(u32x4*)(O + (size_t)row * 1024 + col) = w; } }
    }
};
struct EpiMerge {
    static constexpr bool PERM = true;
    bf16_t* O; const bf16_t* proj;
    __device__ __forceinline__ void operator()(const f32x4 (&acc)[2][2][4][2], const Unit& u, int wr, int wc, int fr, int fq) const {
        const int row0 = u.pm * BM + wr * 64 + fr, col0 = u.pn * BM + wc * 32 + 8 * fq; const int z = u.z;
#pragma unroll
        for (int ai = 0; ai < 2; ++ai)
#pragma unroll
            for (int m = 0; m < 4; ++m) { const int row = row0 + ai * HALF + m * 16;
#pragma unroll
                for (int bj = 0; bj < 2; ++bj) { const int col = col0 + bj * HALF;
                    const u32x4 gv = *(const u32x4*)(proj + (size_t)row * NIN + C_G + z * 2048 + col);
                    u32x4 tv = (u32x4){0u, 0u, 0u, 0u}; if (z > 0) tv = *(const u32x4*)(O + (size_t)row * DM + col);
                    const f32x4 a0 = acc[ai][bj][m][0], a1 = acc[ai][bj][m][1]; float o[8]; const float av[8] = {a0[0], a0[1], a0[2], a0[3], a1[0], a1[1], a1[2], a1[3]};
#pragma unroll
                    for (int j = 0; j < 4; ++j) { const unsigned gw = gv[j], tw = tv[j];
                        o[2 * j] = bflo(tw) + sigmoidf_(bflo(gw)) * av[2 * j]; o[2 * j + 1] = bfhi(tw) + sigmoidf_(bfhi(gw)) * av[2 * j + 1]; }
                    u32x4 w; w.x = cvt_pk_bf16(o[0], o[1]); w.y = cvt_pk_bf16(o[2], o[3]); w.z = cvt_pk_bf16(o[4], o[5]); w.w = cvt_pk_bf16(o[6], o[7]);
                    *(u32x4*)(O + (size_t)row * DM + col) = w; } }
    }
};
struct EpiOut {
    static constexpr bool PERM = false;
    const float* XinP; const float* XinS; float* Xout; bf16_t* XB; float* rsp;
    __device__ __forceinline__ void operator()(const f32x4 (&acc)[2][2][4][2], const Unit& u, int wr, int wc, int fr, int fq) const {
        const int row0 = u.pm * BM + wr * 64 + fr, col0 = u.pn * BM + wc * 32 + 4 * fq;
#pragma unroll
        for (int ai = 0; ai < 2; ++ai)
#pragma unroll
            for (int m = 0; m < 4; ++m) { const int row = row0 + ai * HALF + m * 16;
                const float* xin = (row < MP ? XinP + (size_t)row * DM : XinS + (size_t)(row - MP) * DM) + col0; const size_t off = (size_t)row * DM + col0; float ss = 0.f;
#pragma unroll
                for (int bj = 0; bj < 2; ++bj)
#pragma unroll
                    for (int n = 0; n < 2; ++n) { const f32x4 xi = *(const f32x4*)(xin + bj * HALF + n * 16); const f32x4 xo = xi + acc[ai][bj][m][n];
                        *(f32x4*)(Xout + off + bj * HALF + n * 16) = xo; if (XB) { u32x2 w; w.x = cvt_pk_bf16(xo[0], xo[1]); w.y = cvt_pk_bf16(xo[2], xo[3]); *(u32x2*)(XB + off + bj * HALF + n * 16) = w; }
                        ss += (xo[0] * xo[0] + xo[1] * xo[1]) + (xo[2] * xo[2] + xo[3] * xo[3]); }
                ss += __shfl_xor(ss, 16); ss += __shfl_xor(ss, 32);
                if (fq == 0) rsp[(size_t)row * 32 + u.pn * 4 + wc] = ss; }
    }
};

template <class Epi, int NZ = 1, bool ALIGN_EPI = true, bool SP2 = true>
__device__ __forceinline__ void gemm_phase(LAS unsigned char* lds, const int tid, const Gemm g, const StaticOrder<NZ>& S, const Epi& E) {
    const int wid = __builtin_amdgcn_readfirstlane(tid >> 6), lane = tid & 63, wr = wid >> 2, wc = wid & 3, fr = lane & 15, fq = lane >> 4;
    const int K = g.K, nt = K / BK;
    unsigned voffA[2], voffB[2];
#pragma unroll
    for (int i = 0; i < 2; ++i) { int R, C; stage_rc(tid * 16 + i * 8192, R, C); const int Rb = Epi::PERM ? ((R & ~31) + perm32(R & 31)) : R;
        voffA[i] = (unsigned)(R * K + C) * 2u; voffB[i] = (unsigned)(Rb * K + C) * 2u; }
    const size_t kstep = (size_t)(BK * 2);
    const size_t hstep = (size_t)HALF * K * 2;
    const size_t tstep = 2 * hstep;
    const unsigned ldsw = (unsigned)wid * 1024u;
    const int aoff = lds_byte(wr * 64 + fr, fq * 8), boff = lds_byte(wc * 32 + fr, fq * 8);
#define PG8_SA(b, h) (((b) * 2 + (h)) * HTB)
#define PG8_SB(b, h) ((4 + (b) * 2 + (h)) * HTB)
#define PG8_STAGE(bufoff, gbase, voff) do { _Pragma("unroll") for (int _i = 0; _i < 2; ++_i) \
        __builtin_amdgcn_global_load_lds((const unsigned*)((const char*)(gbase) + (voff)[_i]), (LAS unsigned*)(lds + (bufoff) + ldsw + _i * 8192), 16, 0, 0); } while (0)
#define PG8_LDA(dst, b, h) do { _Pragma("unroll") for (int m = 0; m < 4; ++m) _Pragma("unroll") for (int k = 0; k < 2; ++k) dst[m][k] = *(const LAS bf16x8*)(lds + PG8_SA(b, h) + aoff + m * 2048 + k * 1024); } while (0)
#define PG8_LDB(dst, b, h) do { _Pragma("unroll") for (int n = 0; n < 2; ++n) _Pragma("unroll") for (int k = 0; k < 2; ++k) dst[n][k] = *(const LAS bf16x8*)(lds + PG8_SB(b, h) + boff + n * 2048 + k * 1024); } while (0)
#define PG8_MMA(ai, bj, At, Bt) do { __builtin_amdgcn_s_setprio(1); _Pragma("unroll") for (int m = 0; m < 4; ++m) _Pragma("unroll") for (int n = 0; n < 2; ++n) _Pragma("unroll") for (int k = 0; k < 2; ++k) \
        acc[ai][bj][m][n] = __builtin_amdgcn_mfma_f32_16x16x32_bf16(Bt[n][k], At[m][k], acc[ai][bj][m][n], 0, 0, 0); __builtin_amdgcn_s_setprio(0); } while (0)
#define PG8_WAIT_V(n) asm volatile("s_waitcnt vmcnt(" #n ")" ::: "memory")
#define PG8_WAIT_L(n) asm volatile("s_waitcnt lgkmcnt(" #n ")" ::: "memory")
#define PG8_BAR __builtin_amdgcn_s_barrier()
#define PG8_SCHED __builtin_amdgcn_sched_barrier(0)
    Unit cur, nxt; int ui = 0;
    if (!S.next(0, cur)) return;
    f32x4 acc[2][2][4][2];
#pragma unroll
    for (int a = 0; a < 2; ++a)
#pragma unroll
        for (int b = 0; b < 2; ++b)
#pragma unroll
            for (int m = 0; m < 4; ++m)
#pragma unroll
                for (int n = 0; n < 2; ++n) acc[a][b][m][n] = (f32x4){0.f, 0.f, 0.f, 0.f};
    bf16x8 At[4][2], B0[2][2], B1[2][2];
    const char* cA = selA<NZ>(g, cur.z) + (size_t)cur.pm * tstep; const char* cB = selB<NZ>(g, cur.z) + (size_t)cur.pn * tstep;
    if constexpr (SP2) {
        PG8_STAGE(PG8_SB(0, 0), cB, voffB); PG8_STAGE(PG8_SB(0, 1), cB + hstep, voffB); PG8_STAGE(PG8_SA(0, 0), cA, voffA); PG8_STAGE(PG8_SA(0, 1), cA + hstep, voffA);
        if (wr == 1) PG8_BAR;
        PG8_WAIT_V(2); PG8_BAR;
        PG8_STAGE(PG8_SB(1, 0), cB + kstep, voffB); PG8_STAGE(PG8_SA(1, 0), cA + kstep, voffA); PG8_STAGE(PG8_SB(1, 1), cB + hstep + kstep, voffB);
        PG8_WAIT_V(6); PG8_BAR;
    } else {
        PG8_STAGE(PG8_SB(0, 0), cB, voffB); PG8_STAGE(PG8_SA(0, 0), cA, voffA); PG8_STAGE(PG8_SB(0, 1), cB + hstep, voffB); PG8_STAGE(PG8_SA(0, 1), cA + hstep, voffA);
        if (wr == 1) PG8_BAR;
        PG8_WAIT_V(4); PG8_BAR;
        PG8_STAGE(PG8_SB(1, 0), cB + kstep, voffB); PG8_STAGE(PG8_SA(1, 0), cA + kstep, voffA); PG8_STAGE(PG8_SB(1, 1), cB + hstep + kstep, voffB);
        PG8_WAIT_V(6); PG8_BAR;
    }
    for (;;) {
        const bool has_next = S.next(ui + 1, nxt);
        const char* nA = has_next ? selA<NZ>(g, nxt.z) + (size_t)nxt.pm * tstep : cA; const char* nB = has_next ? selB<NZ>(g, nxt.z) + (size_t)nxt.pn * tstep : cB;
        for (int t = 0; t < nt; t += 2) {
            const bool last = (t == nt - 2);
            const char* a1 = cA + (size_t)(t + 1) * kstep;
            const char* a2 = last ? nA : cA + (size_t)(t + 2) * kstep; const char* b2 = last ? nB : cB + (size_t)(t + 2) * kstep;
            const char* a3 = a2 + kstep; const char* b3 = b2 + kstep;
            if constexpr (SP2) {
            PG8_LDB(B0, 0, 0); PG8_LDB(B1, 0, 1); PG8_SCHED; PG8_LDA(At, 0, 0); PG8_STAGE(PG8_SA(1, 1), a1 + hstep, voffA);
            PG8_WAIT_V(8); PG8_WAIT_L(0); PG8_BAR; PG8_MMA(0, 0, At, B0); PG8_MMA(0, 1, At, B1); PG8_BAR; PG8_SCHED;
            PG8_LDA(At, 0, 1); PG8_STAGE(PG8_SB(0, 0), b2, voffB); PG8_STAGE(PG8_SB(0, 1), b2 + hstep, voffB); PG8_STAGE(PG8_SA(0, 0), a2, voffA);
            PG8_WAIT_V(8); PG8_WAIT_L(0); PG8_BAR; PG8_MMA(1, 0, At, B0); PG8_MMA(1, 1, At, B1); PG8_BAR; PG8_SCHED;
            PG8_LDB(B0, 1, 0); PG8_LDB(B1, 1, 1); PG8_SCHED; PG8_LDA(At, 1, 0); PG8_STAGE(PG8_SA(0, 1), a2 + hstep, voffA);
            PG8_WAIT_V(8); PG8_WAIT_L(0); PG8_BAR; PG8_MMA(0, 0, At, B0); PG8_MMA(0, 1, At, B1); PG8_BAR; PG8_SCHED;
            PG8_LDA(At, 1, 1); PG8_STAGE(PG8_SB(1, 0), b3, voffB); PG8_STAGE(PG8_SB(1, 1), b3 + hstep, voffB); PG8_STAGE(PG8_SA(1, 0), a3, voffA);
            PG8_WAIT_V(8); PG8_WAIT_L(0); PG8_BAR; PG8_MMA(1, 0, At, B0); PG8_MMA(1, 1, At, B1); PG8_BAR; PG8_SCHED;
            } else {
            PG8_LDB(B0, 0, 0); PG8_SCHED; PG8_LDA(At, 0, 0); PG8_STAGE(PG8_SA(1, 1), a1 + hstep, voffA);
            PG8_WAIT_L(8); PG8_BAR; PG8_WAIT_L(0); PG8_MMA(0, 0, At, B0); PG8_BAR; PG8_SCHED;
            PG8_LDB(B1, 0, 1); PG8_STAGE(PG8_SB(0, 0), b2, voffB);
            PG8_BAR; PG8_WAIT_L(0); PG8_MMA(0, 1, At, B1); PG8_BAR;
            PG8_LDA(At, 0, 1); PG8_STAGE(PG8_SA(0, 0), a2, voffA);
            PG8_BAR; PG8_WAIT_L(0); PG8_MMA(1, 0, At, B0); PG8_BAR; PG8_SCHED;
            PG8_STAGE(PG8_SB(0, 1), b2 + hstep, voffB);
            PG8_WAIT_V(6); PG8_BAR; PG8_MMA(1, 1, At, B1); PG8_BAR;
            PG8_LDB(B0, 1, 0); PG8_SCHED; PG8_LDA(At, 1, 0); PG8_STAGE(PG8_SA(0, 1), a2 + hstep, voffA);
            PG8_WAIT_L(8); PG8_BAR; PG8_WAIT_L(0); PG8_MMA(0, 0, At, B0); PG8_BAR; PG8_SCHED;
            PG8_LDB(B1, 1, 1); PG8_STAGE(PG8_SB(1, 0), b3, voffB);
            PG8_BAR; PG8_WAIT_L(0); PG8_MMA(0, 1, At, B1); PG8_BAR;
            PG8_LDA(At, 1, 1); PG8_STAGE(PG8_SA(1, 0), a3, voffA);
            PG8_BAR; PG8_WAIT_L(0); PG8_MMA(1, 0, At, B0); PG8_BAR; PG8_SCHED;
            PG8_STAGE(PG8_SB(1, 1), b3 + hstep, voffB);
            PG8_WAIT_V(6); PG8_BAR; PG8_MMA(1, 1, At, B1); PG8_BAR;
            }
        }
        if constexpr (ALIGN_EPI) { if (wr == 0) PG8_BAR; }
        E(acc, cur, wr, wc, fr, fq);
        if (!has_next) break;
#pragma unroll
        for (int a = 0; a < 2; ++a)
#pragma unroll
            for (int b = 0; b < 2; ++b)
#pragma unroll
                for (int m = 0; m < 4; ++m)
#pragma unroll
                    for (int n = 0; n < 2; ++n) acc[a][b][m][n] = (f32x4){0.f, 0.f, 0.f, 0.f};
        cur = nxt; cA = nA; cB = nB; ++ui;
        if constexpr (ALIGN_EPI) { if (wr == 1) PG8_BAR; }
    }
    PG8_WAIT_V(0);
    if constexpr (!ALIGN_EPI) { if (wr == 0) PG8_BAR; }
    PG8_BAR;
#undef PG8_SA
#undef PG8_SB
#undef PG8_STAGE
#undef PG8_LDA
#undef PG8_LDB
#undef PG8_MMA
#undef PG8_WAIT_V
#undef PG8_WAIT_L
#undef PG8_BAR
#undef PG8_SCHED
}
}

constexpr int NWAVES = 8, NTHR = NWAVES * 64;
constexpr int LDS_BYTES = 147456;
constexpr int LDS_MISC_OFF = 143360;

struct Args { const float* in[32]; float* out; unsigned char* ws; int ph_lo, ph_hi; };

struct Ctx {
    LAS unsigned char* lds;
    int tid, lane, wave, vcu, G, gtid, gthreads, gw, ngw;
    const float* const* in; float* out; unsigned char* ws;
};
__device__ __forceinline__ const float* INP_(const float* const* in, int k) { asm volatile("" : "+s"(k)); return in[k]; }
#define INP(k) INP_(C.in, (k))
#define WSP(T, off) ((T*)(C.ws + (off)))
#define cWIN WSP(bf16_t, WS_WIN)
#define cWGLU WSP(bf16_t, WS_WGLU)
#define cWBR WSP(bf16_t, WS_WBR)
#define cWOUT WSP(bf16_t, WS_WOUT)
#define cMERGED WSP(bf16_t, WS_MERGED)
#define cPROJ WSP(bf16_t, WS_PROJ)
#define cYS5 WSP(bf16_t, WS_YS5)
#define cAS5 WSP(bf16_t, WS_AS5)
#define cALRU WSP(bf16_t, WS_ALRU)
#define cARET WSP(bf16_t, WS_ARET)
#define cLRUP WSP(bf16_t, WS_LRUP)
#define cXB ((bf16_t*)(C.out + O_XB))
#define cKV WSP(float, WS_KV)
#define cS5E WSP(float, WS_S5E)
#define cS5HIN WSP(float, WS_S5HIN)
#define cRS WSP(float, WS_MISC + MI_RS)
#define cRSP WSP(float, WS_MISC + MI_RSP)
#define cS5LB WSP(float, WS_MISC + MI_S5LB)
#define cS5BB WSP(float, WS_MISC + MI_S5BB)
#define cROPE WSP(float, WS_MISC + MI_ROPE)
#define cLSUM WSP(float, WS_MISC + MI_LSUM)
#define cLHIN WSP(float, WS_MISC + MI_LHIN)

__device__ __forceinline__ void transpose_item(const float* W, int K, int N, bf16_t* WT, const float* gk, LAS float* scr, int item, int lane) {
    const int nblk = N / 32, kb = item / nblk, nb = item % nblk, k0 = 64 * kb, n0 = 32 * nb;
#pragma unroll 8
    for (int i = 0; i < 32; ++i) { const int kk = 2 * i + (lane >> 5); float v = W[(size_t)(k0 + kk) * N + n0 + (lane & 31)]; if (gk) v *= gk[k0 + kk]; scr[kk * 33 + (lane & 31)] = v; }
    LDS_WAIT(); asm volatile("" ::: "memory");
    const int c = lane & 7;
#pragma unroll
    for (int j = 0; j < 4; ++j) { const int n = (lane >> 3) + 8 * j; const LAS float* s = scr + (8 * c) * 33 + n;
        u32x4 o; o.x = pk2(s[0 * 33], s[1 * 33]); o.y = pk2(s[2 * 33], s[3 * 33]); o.z = pk2(s[4 * 33], s[5 * 33]); o.w = pk2(s[6 * 33], s[7 * 33]);
        *(u32x4*)(WT + (size_t)(n0 + n) * K + k0 + 8 * c) = o; }
    LDS_WAIT(); asm volatile("" ::: "memory");
}

__device__ __forceinline__ void phase_prep(Ctx& C, int l) {
    const float* in0 = INP(0); const float* in1 = INP(1); const float* in7 = INP(7); const float* in8 = INP(8); const float* in9 = INP(9); const float* in10 = INP(10); const float* in11 = INP(11); const float* in12 = INP(12); const float* in13 = INP(13); const float* in17 = INP(17); const float* in27 = INP(27); const float* in28 = INP(28); const float* in29 = INP(29); const float* in30 = INP(30);
    LAS float* scr = (LAS float*)(C.lds + C.wave * 8448);
    constexpr int I_IN = (DM / 64) * (NIN / 32), I_GLU = (1024 / 64) * (1024 / 32), I_BR = (1024 / 64) * (DM / 32), I_OUT = (DM / 64) * (DM / 32);
    constexpr int NITEMS = I_IN + I_GLU + 3 * I_BR + I_OUT;
    for (int it = C.gw; it < NITEMS; it += C.ngw) {
        int r = it;
        if (r < I_IN) { transpose_item(in8 + (size_t)l * DM * NIN, DM, NIN, cWIN, in7 + l * DM, scr, r, C.lane); continue; } r -= I_IN;
        if (r < I_GLU) { transpose_item(in17 + (size_t)l * 1024 * 1024, 1024, 1024, cWGLU, nullptr, scr, r, C.lane); continue; } r -= I_GLU;
        if (r < I_BR) { transpose_item(in27 + (size_t)l * 1024 * DM, 1024, DM, cWBR, nullptr, scr, r, C.lane); continue; } r -= I_BR;
        if (r < I_BR) { transpose_item(in28 + (size_t)l * 1024 * DM, 1024, DM, cWBR + (size_t)DM * 1024, nullptr, scr, r, C.lane); continue; } r -= I_BR;
        if (r < I_BR) { transpose_item(in29 + (size_t)l * 1024 * DM, 1024, DM, cWBR + (size_t)2 * DM * 1024, nullptr, scr, r, C.lane); continue; } r -= I_BR;
        transpose_item(in30 + (size_t)l * DM * DM, DM, DM, cWOUT, nullptr, scr, r, C.lane);
    }
    if (l == 0) {
        for (int m = C.gw; m < M; m += C.ngw) {
            const float* xr = (m < MP) ? in0 + (size_t)m * DM : in1 + (size_t)(m - MP) * DM;
            float ss = 0.f;
#pragma unroll
            for (int j = 0; j < 8; ++j) { const f32x4 v = *(const f32x4*)(xr + 4 * C.lane + 256 * j); ss += (v[0] * v[0] + v[1] * v[1]) + (v[2] * v[2] + v[3] * v[3]);
                u32x2 w; w.x = pk2(v[0], v[1]); w.y = pk2(v[2], v[3]); *(u32x2*)(cXB + (size_t)m * DM + 4 * C.lane + 256 * j) = w; }
            ss = wave_sum(ss);
            if (C.lane == 0) cRS[m] = 1.0f / sqrtf(ss * (1.0f / DM) + NORM_EPS);
        }
    } else {
        for (int m = C.gtid; m < M; m += C.gthreads) { float ss = 0.f;
#pragma unroll
            for (int j = 0; j < 8; ++j) { const f32x4 v = *(const f32x4*)(cRSP + (size_t)m * 32 + 4 * j); ss += (v[0] + v[1]) + (v[2] + v[3]); }
            cRS[m] = 1.0f / sqrtf(ss * (1.0f / DM) + NORM_EPS); }
    }
    for (int i = C.gtid; i < S5G * S5P; i += C.gthreads) {
        const int g = i >> 6;
        const float dt = expf(in11[l * S5G + g]), lr = in9[l * 4096 + i], li = in10[l * 4096 + i];
        const float a = lr * dt, b = li * dt, ea = expf(a), cb = cosf(b), sb = sinf(b), sh = sinf(0.5f * b);
        const float lbr = ea * cb, lbi = ea * sb;
        const float nr = expm1f(a) * cb - 2.0f * sh * sh, ni = ea * sb, den = lr * lr + li * li;
        const float cr = (nr * lr + ni * li) / den, ci = (ni * lr - nr * li) / den;
        cS5LB[i] = lbr; cS5LB[4096 + i] = lbi;
        float pr = lbr, pi = lbi;
#pragma unroll
        for (int s = 0; s < 6; ++s) { const float t = pr * pr - pi * pi; pi = 2.0f * pr * pi; pr = t; }
        cS5LB[8192 + i] = pr; cS5LB[12288 + i] = pi;
        const float* bre = in12 + ((size_t)l * 4096 + i) * 16; const float* bim = in13 + ((size_t)l * 4096 + i) * 16;
#pragma unroll
        for (int c = 0; c < 16; ++c) { const float br = bre[c], bi = bim[c]; cS5BB[(size_t)i * 16 + c] = cr * br - ci * bi; cS5BB[65536 + (size_t)i * 16 + c] = cr * bi + ci * br; }
    }
    if (l == 0) {
        for (int i = C.gtid; i < 2056 * 64; i += C.gthreads) {
            const int pi_ = i >> 6, j = i & 63; const int pos = pi_ < 2048 ? pi_ : PAST + (pi_ - 2048);
            const float freq = powf(10000.0f, -(float)j / 64.0f); const float ang = (float)pos * freq;
            double r = (double)ang; const double k = rint(r * 0.15915494309189535); r -= k * 6.283185307179586;
            const float rr = (float)r;
            cROPE[i] = cosf(rr); cROPE[2056 * 64 + i] = sinf(rr);
        }
    }
}

__device__ __forceinline__ void s5_pass1(Ctx& C) {
    LAS float* U = (LAS float*)(C.lds + C.wave * 4096);
    const int p = C.lane;
    for (int it = C.gw; it < NB * S5NCH * S5G; it += C.ngw) {
        const int g = it & 63, bj = it >> 6, b = bj / S5NCH, j = bj % S5NCH;
        const int idx = g * 64 + p;
        const float lbr = cS5LB[idx], lbi = cS5LB[4096 + idx];
        float bbr[16], bbi[16];
#pragma unroll
        for (int c = 0; c < 4; ++c) { const f32x4 v = *(const f32x4*)(cS5BB + (size_t)idx * 16 + 4 * c), w = *(const f32x4*)(cS5BB + 65536 + (size_t)idx * 16 + 4 * c);
            bbr[4 * c] = v[0]; bbr[4 * c + 1] = v[1]; bbr[4 * c + 2] = v[2]; bbr[4 * c + 3] = v[3]; bbi[4 * c] = w[0]; bbi[4 * c + 1] = w[1]; bbi[4 * c + 2] = w[2]; bbi[4 * c + 3] = w[3]; }
        { const size_t row = (size_t)b * SEQ + j * S5L + C.lane; const bf16_t* src = cPROJ + row * NIN + C_US5 + g * 16;
          const u32x4 v0 = *(const u32x4*)src, v1 = *(const u32x4*)(src + 8);
          LAS f32x4* d = (LAS f32x4*)(U + C.lane * 16);
          d[0] = (f32x4){bflo(v0.x), bfhi(v0.x), bflo(v0.y), bfhi(v0.y)}; d[1] = (f32x4){bflo(v0.z), bfhi(v0.z), bflo(v0.w), bfhi(v0.w)};
          d[2] = (f32x4){bflo(v1.x), bfhi(v1.x), bflo(v1.y), bfhi(v1.y)}; d[3] = (f32x4){bflo(v1.z), bfhi(v1.z), bflo(v1.w), bfhi(v1.w)}; }
        LDS_WAIT(); asm volatile("" ::: "memory");
        float hr = 0.f, hi = 0.f;
        for (int t = 0; t < S5L; ++t) {
            const LAS f32x4* u4 = (const LAS f32x4*)(U + t * 16); float bur = 0.f, bui = 0.f;
#pragma unroll
            for (int c = 0; c < 4; ++c) { const f32x4 u = u4[c];
#pragma unroll
                for (int k = 0; k < 4; ++k) { bur += bbr[4 * c + k] * u[k]; bui += bbi[4 * c + k] * u[k]; } }
            const float nr = lbr * hr - lbi * hi + bur, ni = lbr * hi + lbi * hr + bui; hr = nr; hi = ni;
        }
        cS5E[(size_t)it * 128 + p] = hr; cS5E[(size_t)it * 128 + 64 + p] = hi;
        LDS_WAIT(); asm volatile("" ::: "memory");
    }
}
__device__ __forceinline__ void s5_carry(Ctx& C, int l) {
    for (int i = C.gtid; i < NB * S5G * S5P; i += C.gthreads) {
        const int b = i >> 12, gp = i & 4095, g = gp >> 6, p = gp & 63;
        const float l64r = cS5LB[8192 + gp], l64i = cS5LB[12288 + gp]; float rr = 0.f, ri = 0.f;
        for (int j = 0; j < S5NCH; ++j) { const size_t o = ((size_t)(b * S5NCH + j) * 64 + g) * 128 + p;
            cS5HIN[o] = rr; cS5HIN[o + 64] = ri; const float er = cS5E[o], ei = cS5E[o + 64];
            const float nr = l64r * rr - l64i * ri + er, ni = l64r * ri + l64i * rr + ei; rr = nr; ri = ni; }
        C.out[O_S5RP + (size_t)(l * NB + b) * 4096 + gp] = rr; C.out[O_S5IP + (size_t)(l * NB + b) * 4096 + gp] = ri;
    }
}
__device__ __forceinline__ void s5_pass2(Ctx& C, int l) {
    const float* in2 = INP(2); const float* in3 = INP(3); const float* in14 = INP(14); const float* in15 = INP(15); const float* in16 = INP(16);
    LAS float* CT = (LAS float*)C.lds;
    LAS float* U = (LAS float*)(C.lds + 8192 + C.wave * 9472);
    LAS float* H = U + 256;
    const int p = C.lane, tt = C.lane >> 2, q = C.lane & 3;
    for (int it = C.vcu; it < 2048; it += C.G) {
        const bool smp = it >= 1024; const int r = smp ? it - 1024 : it, g = r >> 4, k = r & 15, pair = k * 8 + C.wave;
        __syncthreads();
        for (int e = C.tid; e < 2048; e += NTHR) { const int pp = e >> 4, c = e & 15;
            CT[e] = pp < 64 ? in14[((size_t)(l * S5G + g) * 16 + c) * 64 + pp] : -in15[((size_t)(l * S5G + g) * 16 + c) * 64 + (pp - 64)]; }
        __syncthreads();
        const int idx = g * 64 + p;
        const float lbr = cS5LB[idx], lbi = cS5LB[4096 + idx];
        float bbr[16], bbi[16];
#pragma unroll
        for (int c = 0; c < 4; ++c) { const f32x4 v = *(const f32x4*)(cS5BB + (size_t)idx * 16 + 4 * c), w = *(const f32x4*)(cS5BB + 65536 + (size_t)idx * 16 + 4 * c);
            bbr[4 * c] = v[0]; bbr[4 * c + 1] = v[1]; bbr[4 * c + 2] = v[2]; bbr[4 * c + 3] = v[3]; bbi[4 * c] = w[0]; bbi[4 * c + 1] = w[1]; bbi[4 * c + 2] = w[2]; bbi[4 * c + 3] = w[3]; }
        float hr, hi; size_t row0; int ntok;
        if (smp) { const size_t o = ((size_t)(l * DB + pair) * 64 + g) * 64 + p; hr = in2[o]; hi = in3[o]; row0 = (size_t)MP + pair * DS; ntok = DS; }
        else { const int b = pair >> 5, j = pair & 31; const size_t o = ((size_t)(b * S5NCH + j) * 64 + g) * 128 + p; hr = cS5HIN[o]; hi = cS5HIN[o + 64]; row0 = (size_t)b * SEQ + j * S5L; ntok = S5L; }
        const f32x4 dv = *(const f32x4*)(in16 + l * 1024 + g * 16 + 4 * q);
        for (int sb = 0; sb < ntok; sb += 16) {
            const int nts = (ntok - sb) < 16 ? (ntok - sb) : 16;
            { f32x4 uu = (f32x4){0.f, 0.f, 0.f, 0.f};
              if (tt < nts) { const u32x2 v = *(const u32x2*)(cPROJ + (row0 + sb + tt) * NIN + C_US5 + g * 16 + 4 * q); uu = (f32x4){bflo(v.x), bfhi(v.x), bflo(v.y), bfhi(v.y)}; }
              *(LAS f32x4*)(U + tt * 16 + 4 * q) = uu; }
            LDS_WAIT(); asm volatile("" ::: "memory");
            for (int t = 0; t < nts; ++t) {
                const LAS f32x4* u4 = (const LAS f32x4*)(U + t * 16); float bur = 0.f, bui = 0.f;
#pragma unroll
                for (int c = 0; c < 4; ++c) { const f32x4 u = u4[c];
#pragma unroll
                    for (int kk = 0; kk < 4; ++kk) { bur += bbr[4 * c + kk] * u[kk]; bui += bbi[4 * c + kk] * u[kk]; } }
                const float nr = lbr * hr - lbi * hi + bur, ni = lbr * hi + lbi * hr + bui; hr = nr; hi = ni;
                H[t * 132 + p] = hr; H[t * 132 + 64 + p] = hi;
            }
            LDS_WAIT(); asm volatile("" ::: "memory");
            f32x4 acc = (f32x4){0.f, 0.f, 0.f, 0.f};
            if (tt < nts) {
#pragma unroll 4
                for (int p4 = 0; p4 < 32; ++p4) { const f32x4 h4 = *(const LAS f32x4*)(H + tt * 132 + 4 * p4);
#pragma unroll
                    for (int kk = 0; kk < 4; ++kk) { const f32x4 ct = *(const LAS f32x4*)(CT + (4 * p4 + kk) * 16 + 4 * q); acc += h4[kk] * ct; } }
                const f32x4 uu = *(const LAS f32x4*)(U + tt * 16 + 4 * q);
                const f32x4 y = acc + dv * uu;
                u32x2 w; w.x = pk2(gelu_tanh(y[0]), gelu_tanh(y[1])); w.y = pk2(gelu_tanh(y[2]), gelu_tanh(y[3]));
                *(u32x2*)(cYS5 + (row0 + sb + tt) * 1024 + g * 16 + 4 * q) = w;
            }
            LDS_WAIT(); asm volatile("" ::: "memory");
        }
        if (smp) { const size_t o = ((size_t)(l * DB + pair) * 64 + g) * 64 + p; C.out[O_S5RS + o] = hr; C.out[O_S5IS + o] = hi; }
    }
    __syncthreads();
}

__device__ __forceinline__ void lru_tiles(Ctx& C, int l) {
    const float* in4 = INP(4); const float* in5 = INP(5); const float* in19 = INP(19); const float* in20 = INP(20); const float* in21 = INP(21); const float* in22 = INP(22); const float* in23 = INP(23); const float* in24 = INP(24); const float* in25 = INP(25);
    LAS bf16_t* WB = (LAS bf16_t*)C.lds;
    LAS float* XC = (LAS float*)(C.lds + 65536);
    LAS float* SUMS = (LAS float*)(C.lds + 98304);
    constexpr int NTILES = MP / LT + MS / LT;
    for (int it = C.vcu; it < NTILES * 8; it += C.G) {
        const int n = it & 7, tile = it >> 3; const bool smp = tile >= MP / LT;
        const size_t row0 = (size_t)tile * LT;
        __syncthreads();
        { const float* wa = in21 + (size_t)(l * 8 + n) * 16384; const float* wx = in23 + (size_t)(l * 8 + n) * 16384;
#pragma unroll 4
          for (int i = 0; i < 16; ++i) { const int e4 = C.tid + NTHR * i; const int gate = e4 >> 12, rem = (e4 & 4095) * 4;
              const f32x4 v = *(const f32x4*)((gate ? wx : wa) + rem); u32x2 w; w.x = pk2(v[0], v[1]); w.y = pk2(v[2], v[3]);
              *(LAS u32x2*)(WB + gate * 16384 + rem) = w; } }
        { const int tt = C.tid >> 3, cq = C.tid & 7, ch0 = n * 128 + 16 * cq;
          float xc[16];
#pragma unroll
          for (int c = 0; c < 16; ++c) xc[c] = in20[l * 1024 + ch0 + c];
          const int s = smp ? (tt & 7) : ((tile & (LNT - 1)) * LT + tt);
          const int bs = smp ? (tile - MP / LT) * 8 + (tt >> 3) : 0;
#pragma unroll
          for (int k = 0; k < 4; ++k) { const int sr = s - 3 + k; float u[16];
              if (sr >= 0) { const bf16_t* src = cPROJ + (row0 + tt - 3 + k) * NIN + C_ULRU + ch0; const u32x4 v0 = *(const u32x4*)src, v1 = *(const u32x4*)(src + 8);
#pragma unroll
                  for (int j = 0; j < 4; ++j) { u[2 * j] = bflo(v0[j]); u[2 * j + 1] = bfhi(v0[j]); u[8 + 2 * j] = bflo(v1[j]); u[9 + 2 * j] = bfhi(v1[j]); } }
              else if (smp) { const float* src = in5 + ((size_t)(l * DB + bs) * 3 + (sr + 3)) * 1024 + ch0;
#pragma unroll
                  for (int j = 0; j < 4; ++j) { const f32x4 v = *(const f32x4*)(src + 4 * j); u[4 * j] = v[0]; u[4 * j + 1] = v[1]; u[4 * j + 2] = v[2]; u[4 * j + 3] = v[3]; } }
              else {
#pragma unroll
                  for (int c = 0; c < 16; ++c) u[c] = 0.f; }
              const float* cw = in19 + (size_t)(l * 4 + k) * 1024 + ch0;
#pragma unroll
              for (int c = 0; c < 16; ++c) xc[c] += cw[c] * u[c]; }
#pragma unroll
          for (int j = 0; j < 4; ++j) *(LAS f32x4*)(XC + tt * 128 + 16 * cq + 4 * j) = (f32x4){xc[4 * j], xc[4 * j + 1], xc[4 * j + 2], xc[4 * j + 3]}; }
        __syncthreads();
        const int d = C.tid & 127, tg = C.tid >> 7, ch = n * 128 + d;
        float aA[16], aX[16];
#pragma unroll
        for (int t = 0; t < 16; ++t) { aA[t] = 0.f; aX[t] = 0.f; }
        for (int c4 = 0; c4 < 32; ++c4) { float wa[4], wx[4];
#pragma unroll
            for (int k = 0; k < 4; ++k) { wa[k] = bf2f(WB[(4 * c4 + k) * 128 + d]); wx[k] = bf2f(WB[16384 + (4 * c4 + k) * 128 + d]); }
#pragma unroll
            for (int t = 0; t < 16; ++t) { const f32x4 x = *(const LAS f32x4*)(XC + (tg * 16 + t) * 128 + 4 * c4);
                aA[t] += (x[0] * wa[0] + x[1] * wa[1]) + (x[2] * wa[2] + x[3] * wa[3]); aX[t] += (x[0] * wx[0] + x[1] * wx[1]) + (x[2] * wx[2] + x[3] * wx[3]); } }
        { const float ba = in22[l * 1024 + ch], bx_ = in24[l * 1024 + ch], sp = log1pf(expf(-in25[l * 1024 + ch]));
#pragma unroll
          for (int t = 0; t < 16; ++t) { const float r = sigmoidf_(aA[t] + ba), ig = sigmoidf_(aX[t] + bx_), la = -8.0f * r * sp, a = expf(la);
              const float xv = XC[(tg * 16 + t) * 128 + d]; aA[t] = a; aX[t] = sqrtf(fmaxf(-expm1f(2.0f * la), 0.f)) * (ig * xv); } }
        if (!smp) {
            float cA = 1.f, cB = 0.f;
#pragma unroll
            for (int t = 0; t < 16; ++t) { cB = aA[t] * cB + aX[t]; cA *= aA[t]; aX[t] = cB; aA[t] = cA; }
            SUMS[(tg * 128 + d) * 2] = cA; SUMS[(tg * 128 + d) * 2 + 1] = cB;
            __syncthreads();
            float iA = 1.f, iB = 0.f;
            for (int g2 = 0; g2 < tg; ++g2) { const float A2 = SUMS[(g2 * 128 + d) * 2], B2 = SUMS[(g2 * 128 + d) * 2 + 1]; iB = A2 * iB + B2; iA *= A2; }
#pragma unroll
            for (int t = 0; t < 16; ++t) { aX[t] += aA[t] * iB; aA[t] *= iA; }
            if (tg == 3) { cLSUM[((size_t)tile * 1024 + ch) * 2] = aA[15]; cLSUM[((size_t)tile * 1024 + ch) * 2 + 1] = aX[15];
                if ((tile & (LNT - 1)) == LNT - 1) { const int b = tile / LNT;
#pragma unroll
                    for (int k = 0; k < 3; ++k) C.out[O_CONVP + ((size_t)(l * NB + b) * 3 + k) * 1024 + ch] = bf2f(cPROJ[(row0 + 61 + k) * NIN + C_ULRU + ch]); } }
        } else {
#pragma unroll
            for (int sq = 0; sq < 2; ++sq) { const int bs = (tile - MP / LT) * 8 + tg * 2 + sq; float h = in4[(size_t)(l * DB + bs) * 1024 + ch];
#pragma unroll
                for (int t = 0; t < 8; ++t) { h = aA[sq * 8 + t] * h + aX[sq * 8 + t]; aX[sq * 8 + t] = h; aA[sq * 8 + t] = 0.f; }
                C.out[O_LRUS + (size_t)(l * DB + bs) * 1024 + ch] = h;
#pragma unroll
                for (int k = 0; k < 3; ++k) C.out[O_CONVS + ((size_t)(l * DB + bs) * 3 + k) * 1024 + ch] = bf2f(cPROJ[(row0 + tg * 16 + sq * 8 + 5 + k) * NIN + C_ULRU + ch]); }
        }
#pragma unroll
        for (int t = 0; t < 16; ++t) { const size_t o = (row0 + tg * 16 + t) * 1024 + ch; cALRU[o] = (bf16_t)f2bf(aX[t]); cLRUP[o] = (bf16_t)f2bf(aA[t]); }
    }
    __syncthreads();
}
__device__ __forceinline__ void lru_carry(Ctx& C, int l) {
    for (int i = C.gtid; i < NB * 1024; i += C.gthreads) { const int b = i >> 10, ch = i & 1023; float run = 0.f;
        for (int t = 0; t < LNT; ++t) { const size_t o = (size_t)(b * LNT + t) * 1024 + ch; cLHIN[o] = run; run = cLSUM[o * 2] * run + cLSUM[o * 2 + 1]; }
        C.out[O_LRUP + (size_t)(l * NB + b) * 1024 + ch] = run; }
}
__device__ __forceinline__ void lru_fin(Ctx& C) {
    for (int i = C.gtid; i < M * 128; i += C.gthreads) { const int row = i >> 7, c8 = (i & 127) * 8;
        const u32x4 hv = *(const u32x4*)(cALRU + (size_t)row * 1024 + c8), pv = *(const u32x4*)(cLRUP + (size_t)row * 1024 + c8), zv = *(const u32x4*)(cPROJ + (size_t)row * NIN + C_ZLRU + c8);
        f32x4 h0 = (f32x4){0.f, 0.f, 0.f, 0.f}, h1 = h0;
        if (row < MP) { const float* hp = cLHIN + (size_t)(row >> 6) * 1024 + c8; h0 = *(const f32x4*)hp; h1 = *(const f32x4*)(hp + 4); }
        u32x4 w;
        const float hh[8] = {h0[0], h0[1], h0[2], h0[3], h1[0], h1[1], h1[2], h1[3]};
#pragma unroll
        for (int j = 0; j < 4; ++j) {
            const float ya = bflo(hv[j]) + bflo(pv[j]) * hh[2 * j], yb = bfhi(hv[j]) + bfhi(pv[j]) * hh[2 * j + 1];
            w[j] = pk2(ya * siluf_(bflo(zv[j])), yb * siluf_(bfhi(zv[j]))); }
        *(u32x4*)(cALRU + (size_t)row * 1024 + c8) = w; }
}

constexpr int TP = 136;
__device__ __forceinline__ void wave_mma_128(const LAS bf16_t* A, int arow0, const LAS bf16_t* Bt, f32x4 (&acc)[8], int lane) {
    const int fr = lane & 15, fq = lane >> 4;
#pragma unroll
    for (int k = 0; k < 4; ++k) { const bf16x8 a = *(const LAS bf16x8*)(A + (arow0 + fr) * TP + k * 32 + fq * 8);
#pragma unroll
        for (int nt = 0; nt < 8; ++nt) { const bf16x8 b = *(const LAS bf16x8*)(Bt + (nt * 16 + fr) * TP + k * 32 + fq * 8);
            acc[nt] = __builtin_amdgcn_mfma_f32_16x16x32_bf16(a, b, acc[nt], 0, 0, 0); } }
}
__device__ __forceinline__ float ret_logg(int h) { return log1pf(-exp2f(-5.0f - (float)h)); }
__device__ __forceinline__ void rope_load(Ctx& C, size_t row, int colb, int posidx, int qd, float (&o1)[16], float (&o2)[16]) {
    const bf16_t* src = cPROJ + row * NIN + colb + 16 * qd;
    const u32x4 a0 = *(const u32x4*)src, a1 = *(const u32x4*)(src + 8), b0 = *(const u32x4*)(src + 64), b1 = *(const u32x4*)(src + 72);
    const float* cs = cROPE + (size_t)posidx * 64 + 16 * qd; const float* sn = cs + 2056 * 64;
    float x1[16], x2[16];
#pragma unroll
    for (int j = 0; j < 4; ++j) { x1[2 * j] = bflo(a0[j]); x1[2 * j + 1] = bfhi(a0[j]); x1[8 + 2 * j] = bflo(a1[j]); x1[9 + 2 * j] = bfhi(a1[j]);
        x2[2 * j] = bflo(b0[j]); x2[2 * j + 1] = bfhi(b0[j]); x2[8 + 2 * j] = bflo(b1[j]); x2[9 + 2 * j] = bfhi(b1[j]); }
#pragma unroll
    for (int j = 0; j < 4; ++j) { const f32x4 c = *(const f32x4*)(cs + 4 * j), s = *(const f32x4*)(sn + 4 * j);
#pragma unroll
        for (int k = 0; k < 4; ++k) { o1[4 * j + k] = x1[4 * j + k] * c[k] - x2[4 * j + k] * s[k]; o2[4 * j + k] = x1[4 * j + k] * s[k] + x2[4 * j + k] * c[k]; } }
}
__device__ __forceinline__ void load_vt(Ctx& C, LAS bf16_t* VT, size_t row0, int h) {
    const int tok = C.tid >> 2, qd = C.tid & 3; const bf16_t* src = cPROJ + (row0 + tok) * NIN + C_V + h * 128 + 32 * qd;
#pragma unroll
    for (int j = 0; j < 4; ++j) { const u32x4 v = *(const u32x4*)(src + 8 * j);
#pragma unroll
        for (int k = 0; k < 4; ++k) { VT[(32 * qd + 8 * j + 2 * k) * TP + tok] = (bf16_t)(v[k] & 0xffffu); VT[(32 * qd + 8 * j + 2 * k + 1) * TP + tok] = (bf16_t)(v[k] >> 16); } }
}
__device__ __forceinline__ void ret_pass1(Ctx& C) {
    LAS bf16_t* KT = (LAS bf16_t*)C.lds; LAS bf16_t* VT = KT + 128 * TP;
    for (int it = C.vcu; it < NB * NH * NCH; it += C.G) {
        const int j = it & 15, bh = it >> 4, h = bh & 7, b = bh >> 3; const size_t row0 = (size_t)b * SEQ + j * RC;
        const float lg = ret_logg(h);
        __syncthreads();
        { const int tok = C.tid >> 2, qd = C.tid & 3; float k1[16], k2[16];
          rope_load(C, row0 + tok, C_K + h * 128, j * RC + tok, qd, k1, k2);
          const float sc = 0.08838834764831845f * expf((float)(RC - 1 - tok) * lg);
#pragma unroll
          for (int i = 0; i < 16; ++i) { KT[(16 * qd + i) * TP + tok] = (bf16_t)f2bf(k1[i] * sc); KT[(64 + 16 * qd + i) * TP + tok] = (bf16_t)f2bf(k2[i] * sc); } }
        load_vt(C, VT, row0, h);
        __syncthreads();
        f32x4 acc[8];
#pragma unroll
        for (int nt = 0; nt < 8; ++nt) acc[nt] = (f32x4){0.f, 0.f, 0.f, 0.f};
        wave_mma_128(KT, 16 * C.wave, VT, acc, C.lane);
        float* dst = cKV + (size_t)it * 16384;
#pragma unroll
        for (int nt = 0; nt < 8; ++nt)
#pragma unroll
            for (int r = 0; r < 4; ++r) dst[(16 * C.wave + (C.lane >> 4) * 4 + r) * 128 + 16 * nt + (C.lane & 15)] = acc[nt][r];
    }
    __syncthreads();
}
__device__ __forceinline__ void ret_prefix(Ctx& C, int l) {
    for (int i = C.gtid; i < NB * NH * 16384; i += C.gthreads) { const int bh = i >> 14, e = i & 16383, h = bh & 7;
        const float gc = expf((float)RC * ret_logg(h)); float run = 0.f;
        for (int j = 0; j < NCH; ++j) { float* p = cKV + ((size_t)bh * NCH + j) * 16384 + e; const float t = *p; *p = run; run = gc * run + t; }
        C.out[O_RETP + (size_t)(l * NB * NH + bh) * 16384 + e] = run; }
}
__device__ __forceinline__ void ret_pass2(Ctx& C, int l) {
    const float* in26 = INP(26);
    LAS bf16_t* QS = (LAS bf16_t*)C.lds; LAS bf16_t* KS = QS + 128 * TP; LAS bf16_t* VT = KS + 128 * TP; LAS bf16_t* RT = VT + 128 * TP;
    for (int it = C.vcu; it < NB * NH * NCH; it += C.G) {
        const int j = it & 15, bh = it >> 4, h = bh & 7, b = bh >> 3; const size_t row0 = (size_t)b * SEQ + j * RC;
        const float lg = ret_logg(h);
        __syncthreads();
        { const int tok = C.tid >> 2, qd = C.tid & 3; float a1[16], a2[16];
          rope_load(C, row0 + tok, C_Q + h * 128, j * RC + tok, qd, a1, a2);
#pragma unroll
          for (int i = 0; i < 2; ++i) { u32x4 w, w2;
#pragma unroll
              for (int k = 0; k < 4; ++k) { w[k] = pk2(a1[8 * i + 2 * k], a1[8 * i + 2 * k + 1]); w2[k] = pk2(a2[8 * i + 2 * k], a2[8 * i + 2 * k + 1]); }
              *(LAS u32x4*)(QS + tok * TP + 16 * qd + 8 * i) = w; *(LAS u32x4*)(QS + tok * TP + 64 + 16 * qd + 8 * i) = w2; }
          rope_load(C, row0 + tok, C_K + h * 128, j * RC + tok, qd, a1, a2);
          const float sc = 0.08838834764831845f;
#pragma unroll
          for (int i = 0; i < 2; ++i) { u32x4 w, w2;
#pragma unroll
              for (int k = 0; k < 4; ++k) { w[k] = pk2(a1[8 * i + 2 * k] * sc, a1[8 * i + 2 * k + 1] * sc); w2[k] = pk2(a2[8 * i + 2 * k] * sc, a2[8 * i + 2 * k + 1] * sc); }
              *(LAS u32x4*)(KS + tok * TP + 16 * qd + 8 * i) = w; *(LAS u32x4*)(KS + tok * TP + 64 + 16 * qd + 8 * i) = w2; } }
        load_vt(C, VT, row0, h);
        { const int d = C.tid >> 2, eq = C.tid & 3; const float* src = cKV + (size_t)it * 16384 + d * 128 + 32 * eq;
#pragma unroll
          for (int k = 0; k < 8; ++k) { const f32x4 v = *(const f32x4*)(src + 4 * k);
#pragma unroll
              for (int i = 0; i < 4; ++i) RT[(32 * eq + 4 * k + i) * TP + d] = (bf16_t)f2bf(v[i]); } }
        __syncthreads();
        const int ib = 16 * C.wave + (C.lane >> 4) * 4, jc = C.lane & 15;
        f32x4 acc[8], s[8];
#pragma unroll
        for (int nt = 0; nt < 8; ++nt) { acc[nt] = (f32x4){0.f, 0.f, 0.f, 0.f}; s[nt] = (f32x4){0.f, 0.f, 0.f, 0.f}; }
        wave_mma_128(QS, 16 * C.wave, RT, acc, C.lane);
#pragma unroll
        for (int r = 0; r < 4; ++r) { const float xi = expf((float)(ib + r + 1) * lg);
#pragma unroll
            for (int nt = 0; nt < 8; ++nt) acc[nt][r] *= xi; }
        wave_mma_128(QS, 16 * C.wave, KS, s, C.lane);
        __syncthreads();
#pragma unroll
        for (int nt = 0; nt < 8; ++nt)
#pragma unroll
            for (int r = 0; r < 4; ++r) { const int i = ib + r, jj = 16 * nt + jc; const float dm = (i >= jj) ? expf((float)(i - jj) * lg) : 0.f;
                KS[i * TP + jj] = (bf16_t)f2bf(s[nt][r] * dm); }
        LDS_WAIT(); asm volatile("" ::: "memory");
        wave_mma_128(KS, 16 * C.wave, VT, acc, C.lane);
#pragma unroll
        for (int r = 0; r < 4; ++r) { float s1 = 0.f;
#pragma unroll
            for (int nt = 0; nt < 8; ++nt) s1 += acc[nt][r];
            s1 += __shfl_xor(s1, 1); s1 += __shfl_xor(s1, 2); s1 += __shfl_xor(s1, 4); s1 += __shfl_xor(s1, 8);
            const float mu = s1 * (1.0f / 128.0f); float s2 = 0.f;
#pragma unroll
            for (int nt = 0; nt < 8; ++nt) { const float dlt = acc[nt][r] - mu; s2 += dlt * dlt; }
            s2 += __shfl_xor(s2, 1); s2 += __shfl_xor(s2, 2); s2 += __shfl_xor(s2, 4); s2 += __shfl_xor(s2, 8);
            const float rstd = 1.0f / sqrtf(s2 * (1.0f / 128.0f) + GN_EPS); const size_t row = row0 + ib + r;
#pragma unroll
            for (int nt = 0; nt < 8; ++nt) { const int e = 16 * nt + jc; const float z = bf2f(cPROJ[row * NIN + C_ZRET + h * 128 + e]);
                cARET[row * 1024 + h * 128 + e] = (bf16_t)f2bf((acc[nt][r] - mu) * rstd * in26[l * 1024 + h * 128 + e] * siluf_(z)); } }
    }
    __syncthreads();
}
__device__ __forceinline__ void ret_sample(Ctx& C, int l) {
    const float* in6 = INP(6); const float* in26 = INP(26);
    LAS float* qs = (LAS float*)C.lds; LAS float* ks = qs + 1024; LAS float* vs = ks + 1024; LAS float* SM = vs + 1024; LAS float* OP = SM + 64;
    for (int it = C.vcu; it < DB * NH; it += C.G) {
        const int h = it & 7, bs = it >> 3; const size_t row0 = (size_t)MP + bs * DS; const float lg = ret_logg(h);
        __syncthreads();
        { const int tok = C.tid >> 6, x = C.tid & 63; const bf16_t* pr = cPROJ + (row0 + tok) * NIN + h * 128;
          const float c = cROPE[(size_t)(2048 + tok) * 64 + x], sn = cROPE[(size_t)2056 * 64 + (size_t)(2048 + tok) * 64 + x];
          const float q1 = bf2f(pr[C_Q + x]), q2 = bf2f(pr[C_Q + 64 + x]), k1 = bf2f(pr[C_K + x]), k2 = bf2f(pr[C_K + 64 + x]);
          qs[tok * 128 + x] = q1 * c - q2 * sn; qs[tok * 128 + 64 + x] = q1 * sn + q2 * c;
          ks[tok * 128 + x] = (k1 * c - k2 * sn) * 0.08838834764831845f; ks[tok * 128 + 64 + x] = (k1 * sn + k2 * c) * 0.08838834764831845f;
          vs[tok * 128 + x] = bf2f(pr[C_V + x]); vs[tok * 128 + 64 + x] = bf2f(pr[C_V + 64 + x]); }
        __syncthreads();
        if (C.tid < 64) { const int i = C.tid >> 3, jj = C.tid & 7; float a = 0.f;
            for (int d = 0; d < 128; ++d) a += qs[i * 128 + d] * ks[jj * 128 + d];
            SM[C.tid] = a; }
        { const int e = C.tid & 127, dq = C.tid >> 7; float v8[8], oacc[8], gz[8];
          const float g8 = expf(8.0f * lg);
#pragma unroll
          for (int t = 0; t < 8; ++t) { v8[t] = vs[t * 128 + e]; oacc[t] = 0.f; gz[t] = expf((float)(7 - t) * lg); }
          const float* rin = in6 + ((size_t)(l * DB + bs) * NH + h) * 16384; float* rout = C.out + O_RETS + ((size_t)(l * DB + bs) * NH + h) * 16384;
#pragma unroll 4
          for (int dd = 0; dd < 32; ++dd) { const int d = 32 * dq + dd; const float r = rin[d * 128 + e]; float rn = g8 * r;
#pragma unroll
              for (int t = 0; t < 8; ++t) { oacc[t] += qs[t * 128 + d] * r; rn += gz[t] * ks[t * 128 + d] * v8[t]; }
              rout[d * 128 + e] = rn; }
#pragma unroll
          for (int t = 0; t < 8; ++t) OP[(dq * 8 + t) * 128 + e] = oacc[t]; }
        __syncthreads();
        { const int tok = C.tid >> 6, x = C.tid & 63; float o[2];
#pragma unroll
          for (int hh = 0; hh < 2; ++hh) { const int e = x + 64 * hh; float a = (OP[(0 * 8 + tok) * 128 + e] + OP[(1 * 8 + tok) * 128 + e]) + (OP[(2 * 8 + tok) * 128 + e] + OP[(3 * 8 + tok) * 128 + e]);
              a *= expf((float)(tok + 1) * lg);
              for (int jj = 0; jj <= tok; ++jj) a += expf((float)(tok - jj) * lg) * SM[tok * 8 + jj] * vs[jj * 128 + e];
              o[hh] = a; }
          const float mu = wave_sum(o[0] + o[1]) * (1.0f / 128.0f); const float d0 = o[0] - mu, d1 = o[1] - mu;
          const float rstd = 1.0f / sqrtf(wave_sum(d0 * d0 + d1 * d1) * (1.0f / 128.0f) + GN_EPS);
          const bf16_t* pr = cPROJ + (row0 + tok) * NIN + C_ZRET + h * 128; bf16_t* dst = cARET + (row0 + tok) * 1024 + h * 128; const float* gn = in26 + l * 1024 + h * 128;
          dst[x] = (bf16_t)f2bf(d0 * rstd * gn[x] * siluf_(bf2f(pr[x]))); dst[x + 64] = (bf16_t)f2bf(d1 * rstd * gn[x + 64] * siluf_(bf2f(pr[x + 64]))); }
    }
    __syncthreads();
}

__device__ __forceinline__ void phase_final(Ctx& C) {
    const float* in31 = INP(31);
    for (int m = C.gw; m < M; m += C.ngw) { float ss = 0.f;
        if (C.lane < 32) ss = cRSP[(size_t)m * 32 + C.lane];
        ss = wave_sum(ss); const float rs = 1.0f / sqrtf(ss * (1.0f / DM) + NORM_EPS);
        float* xr = C.out + (size_t)m * DM;
#pragma unroll
        for (int j = 0; j < 8; ++j) { const int c = 4 * C.lane + 256 * j; const f32x4 v = *(const f32x4*)(xr + c), g = *(const f32x4*)(in31 + c); *(f32x4*)(xr + c) = v * rs * g; } }
}

constexpr int PH_PER_LAYER = 8, N_PHASES = 2 * PH_PER_LAYER + 1;
__global__ void __launch_bounds__(NTHR, 2) fwd_kernel(Args args) {
    extern __shared__ __attribute__((aligned(16))) unsigned char lds_raw[];
    Ctx C;
    C.lds = (LAS unsigned char*)lds_raw;
    C.in = args.in;
    for (int ph = args.ph_lo; ph < args.ph_hi; ++ph) {
        int bid = (int)blockIdx.x, tidv = (int)threadIdx.x, gdim = (int)gridDim.x; asm volatile("" : "+s"(bid), "+v"(tidv), "+s"(gdim));
        C.tid = tidv; C.lane = C.tid & 63; C.wave = __builtin_amdgcn_readfirstlane(C.tid >> 6);
        C.G = gdim; C.vcu = (C.G % 8 == 0) ? (bid % 8) * (C.G / 8) + bid / 8 : bid;
        C.gtid = C.vcu * NTHR + C.tid; C.gthreads = C.G * NTHR; C.gw = C.vcu * NWAVES + C.wave; C.ngw = C.G * NWAVES;
        { unsigned long long w = (unsigned long long)args.ws, o = (unsigned long long)args.out; asm volatile("" : "+s"(w), "+s"(o));
          C.ws = (unsigned char*)w; C.out = (float*)o; }
        if (ph == N_PHASES - 1) { phase_final(C); }
        else {
            const int l = ph / PH_PER_LAYER, k = ph % PH_PER_LAYER;
            if (k == 0) { if (PHMASK & 1) phase_prep(C, l); }
            else if (k == 1) { if (PHMASK & 2) { pg8::Gemm g{}; g.A = cXB; g.Bt = cWIN; g.K = DM; pg8::StaticOrder<1> S; S.init(M, NIN, C.G, bid);
                pg8::EpiProj E{cPROJ, cRS}; pg8::gemm_phase<pg8::EpiProj>(C.lds, C.tid, g, S, E); } }
            else if (k == 2) { if (PHMASK & 4) s5_pass1(C); if (PHMASK & 8) lru_tiles(C, l); if (PHMASK & 16) ret_pass1(C); if (PHMASK & 32) ret_sample(C, l); }
            else if (k == 3) { if (PHMASK & 64) { s5_carry(C, l); lru_carry(C, l); ret_prefix(C, l); } }
            else if (k == 4) { if (PHMASK & 128) s5_pass2(C, l); if (PHMASK & 256) lru_fin(C); if (PHMASK & 512) ret_pass2(C, l); }
            else if (k == 5) { if (PHMASK & 1024) { pg8::Gemm g{}; g.A = cYS5; g.Bt = cWGLU; g.K = 1024; pg8::StaticOrder<1> S; S.init(M, 1024, C.G, bid);
                pg8::EpiGlu E{cAS5, cYS5, cPROJ, INP(18) + l * 1024}; pg8::gemm_phase<pg8::EpiGlu>(C.lds, C.tid, g, S, E); } }
            else if (k == 6) { if (PHMASK & 2048) { pg8::Gemm g{}; g.A = cAS5; g.Bt = cWBR; g.zA = WS_ALRU - WS_AS5; g.zB = (size_t)DM * 1024 * 2; g.K = 1024;
                pg8::StaticOrder<3> S; S.init(M, DM, C.G, bid);
                pg8::EpiMerge E{cMERGED, cPROJ}; pg8::gemm_phase<pg8::EpiMerge, 3>(C.lds, C.tid, g, S, E); } }
            else { if (PHMASK & 4096) { pg8::Gemm g{}; g.A = cMERGED; g.Bt = cWOUT; g.K = DM; pg8::StaticOrder<1> S; S.init(M, DM, C.G, bid);
                const float* x0 = INP(0); const float* x1 = INP(1); pg8::EpiOut E{l == 0 ? x0 : C.out, l == 0 ? x1 : C.out + (size_t)MP * DM, C.out, l == 0 ? cXB : (bf16_t*)nullptr, cRSP}; pg8::gemm_phase<pg8::EpiOut>(C.lds, C.tid, g, S, E); } }
        }
        if (ph + 1 < args.ph_hi) { cg::this_grid().sync(); }
    }
}


#ifdef PROBE_TABLE
__global__ void probe_kernel(float* out) {
    const float tab[12][2] = PROBE_TABLE;
    const size_t offs[13] = {O_YP, O_YS, O_S5RP, O_S5IP, O_LRUP, O_CONVP, O_RETP, O_S5RS, O_S5IS, O_LRUS, O_CONVS, O_RETS, O_END};
    for (int o = 0; o < 12; ++o) { const size_t n = offs[o + 1] - offs[o], half = n / 2;
        for (size_t i = (size_t)blockIdx.x * blockDim.x + threadIdx.x; i < n; i += (size_t)gridDim.x * blockDim.x) { const float s = (o < 2) ? tab[o][0] : tab[o][i >= half];
            out[offs[o] + i] = (s == 0.f) ? 0.f : out[offs[o] + i] * s; } }
}
#endif

extern "C" void kernel_launch(void* const* d_in, const int* in_sizes, int n_in, void* d_out, int out_size, void* d_ws, size_t ws_size, hipStream_t stream) {
    static int grid = 0;
    if (grid == 0) {
        if (n_in != 32 || out_size != (int)O_END || ws_size < WS_END) { fprintf(stderr, "kernel_launch: unexpected shapes: n_in %d out %d ws %zu (need %zu)\n", n_in, out_size, ws_size, (size_t)WS_END); grid = -1; return; }
        int dev = 0, cus = 0, per_cu = 0;
        if (hipGetDevice(&dev) != hipSuccess || hipDeviceGetAttribute(&cus, hipDeviceAttributeMultiprocessorCount, dev) != hipSuccess) { grid = -1; return; }
        if (hipFuncSetAttribute((const void*)fwd_kernel, hipFuncAttributeMaxDynamicSharedMemorySize, LDS_BYTES) != hipSuccess) { fprintf(stderr, "kernel_launch: hipFuncSetAttribute failed\n"); grid = -1; return; }
        if (hipOccupancyMaxActiveBlocksPerMultiprocessor(&per_cu, (const void*)fwd_kernel, NTHR, LDS_BYTES) != hipSuccess || per_cu < 1) { fprintf(stderr, "kernel_launch: occupancy query says %d\n", per_cu); per_cu = 1; }
        (void)hipGetLastError();
        grid = cus;
    }
    if (grid < 0) return;
    (void)hipMemsetAsync((char*)d_ws + WS_CTL, 0, CTL_ZERO_BYTES, stream);
    Args a{};
    for (int i = 0; i < 32; ++i) a.in[i] = (const float*)d_in[i];
    a.out = (float*)d_out; a.ws = (unsigned char*)d_ws;
#if MK_N_LAUNCHES == 1
    a.ph_lo = 0; a.ph_hi = N_PHASES;
    void* kargs[] = {&a};
    hipError_t e = hipLaunchCooperativeKernel((const void*)fwd_kernel, dim3(grid), dim3(NTHR), kargs, LDS_BYTES, stream);
    if (e != hipSuccess) fprintf(stderr, "kernel_launch: cooperative launch failed: %s (grid %d)\n", hipGetErrorString(e), grid);
#else
    for (int ph = 0; ph < N_PHASES; ++ph) { a.ph_lo = ph; a.ph_hi = ph + 1; hipLaunchKernelGGL(fwd_kernel, dim3(grid), dim3(NTHR), LDS_BYTES, stream, a); }
#endif
#ifdef PROBE_TABLE
    hipLaunchKernelGGL(probe_kernel, dim3(2048), dim3(256), 0, stream, (float*)d_out);
#endif
}
```

```cpp
#include <hip/hip_runtime.h>
#include <hip/hip_cooperative_groups.h>
#include <cstdio>
#include <cstdint>
namespace cg = cooperative_groups;

#ifndef PHMASK
#define PHMASK 0xFFFF
#endif
#ifndef MK_N_LAUNCHES
#define MK_N_LAUNCHES 1
#endif

#define LAS __attribute__((address_space(3)))
#define GAS __attribute__((address_space(1)))
typedef unsigned short bf16_t;
typedef short bf16x8 __attribute__((ext_vector_type(8)));
typedef float f32x4 __attribute__((ext_vector_type(4)));
typedef float f32x2 __attribute__((ext_vector_type(2)));
typedef unsigned u32x4 __attribute__((ext_vector_type(4)));
typedef unsigned u32x2 __attribute__((ext_vector_type(2)));

constexpr int DM = 2048, NB = 4, SEQ = 2048, DEPTH = 2, DB = 128, DS = 8, PAST = 16384;
constexpr int MP = NB * SEQ, MS = DB * DS, M = MP + MS;
constexpr int NIN = 14336;
constexpr int C_US5 = 0, C_ZS5 = 1024, C_ULRU = 2048, C_ZLRU = 3072, C_Q = 4096, C_K = 5120, C_V = 6144, C_ZRET = 7168, C_G = 8192;
constexpr int NH = 8, DK = 128, DV = 128, RC = 128, NCH = SEQ / RC;
constexpr int S5G = 64, S5P = 64, S5C = 16;
constexpr int S5L = 64, S5NCH = SEQ / S5L;
constexpr int LT = 64, LNT = SEQ / LT;
constexpr float NORM_EPS = 1e-6f, GN_EPS = 1e-5f;

constexpr size_t O_YP = 0, O_YS = 16777216, O_S5RP = 18874368, O_S5IP = 18907136, O_LRUP = 18939904, O_CONVP = 18948096, O_RETP = 18972672,
                 O_S5RS = 20021248, O_S5IS = 21069824, O_LRUS = 22118400, O_CONVS = 22380544, O_RETS = 23166976, O_END = 56721408;
constexpr size_t O_XB = O_RETS + 16777216;

constexpr size_t MiB = 1u << 20;
constexpr size_t WS_CTL = 0, CTL_ZERO_BYTES = 1 * MiB;
constexpr size_t WS_WIN = 1 * MiB, WS_WGLU = 57 * MiB, WS_WBR = 59 * MiB, WS_WOUT = 71 * MiB, WS_MERGED = 79 * MiB, WS_PROJ = 115 * MiB,
                 WS_YS5 = 367 * MiB, WS_AS5 = 385 * MiB, WS_ALRU = 403 * MiB, WS_ARET = 421 * MiB, WS_KV = 439 * MiB, WS_S5E = 471 * MiB, WS_S5HIN = 475 * MiB,
                 WS_MISC = 479 * MiB, WS_SMALL1 = 487 * MiB, WS_END = 509 * MiB;
constexpr size_t WS_LSTRIDE = WS_SMALL1 - WS_WGLU;
static_assert(WS_ALRU - WS_AS5 == WS_ARET - WS_ALRU, "branch operands equally spaced");
constexpr size_t WS_LRUP = WS_AS5;
constexpr size_t MI_RS = 0;
constexpr size_t MI_RSP = 64 * 1024;
constexpr size_t MI_S5LB = MI_RSP + (size_t)M * 32 * 4;
constexpr size_t MI_S5BB = MI_S5LB + 2 * 4 * 4096 * 4;
constexpr size_t MI_ROPE = MI_S5BB + 2 * 2 * 65536 * 4;
constexpr size_t MI_LSUM = MI_ROPE + 2 * 2056 * 64 * 4;
constexpr size_t MI_LHIN = MI_LSUM + (size_t)NB * LNT * 1024 * 2 * 4;
constexpr size_t MI_WLRU = MI_LHIN + (size_t)NB * LNT * 1024 * 4;
constexpr size_t MI_END = MI_WLRU + (size_t)2 * 8 * 256 * 128 * 2;
static_assert(MI_END <= 8 * MiB, "misc region");

__device__ __forceinline__ float bf2f(unsigned b) { return __uint_as_float(b << 16); }
__device__ __forceinline__ unsigned f2bf(float f) { unsigned u = __float_as_uint(f); return (u + 0x7fffu + ((u >> 16) & 1u)) >> 16; }
__device__ __forceinline__ unsigned pk2(float lo, float hi) { return f2bf(lo) | (f2bf(hi) << 16); }
__device__ __forceinline__ float bflo(unsigned w) { return __uint_as_float(w << 16); }
__device__ __forceinline__ float bfhi(unsigned w) { return __uint_as_float(w & 0xffff0000u); }
__device__ __forceinline__ float sigmoidf_(float x) { return 1.0f / (1.0f + __expf(-x)); }
__device__ __forceinline__ float siluf_(float x) { return x / (1.0f + __expf(-x)); }
__device__ __forceinline__ float gelu_tanh(float x) { const float u = 1.5957691216f * (x + 0.044715f * x * x * x); return x / (1.0f + __expf(-u)); }
__device__ __forceinline__ float wave_sum(float v) {
#pragma unroll
    for (int o = 1; o < 64; o <<= 1) v += __shfl_xor(v, o);
    return v;
}
#define LDS_WAIT() asm volatile("s_waitcnt lgkmcnt(0)" ::: "memory")
#define VM_WAIT() asm volatile("s_waitcnt vmcnt(0)" ::: "memory")

namespace pg8 {
constexpr int BM = 256, BK = 64, HALF = 128, HTB = HALF * BK * 2, STAGE_BYTES = 8 * HTB, NXCD = 8, WGM = 8;
__host__ __device__ __forceinline__ int lds_byte(int r, int c) { const int st = (r >> 4) * 2 + (c >> 5), rr = r & 15, cc = c & 31, ob = rr * 64 + cc * 2; return st * 1024 + (ob ^ (((ob >> 9) & 1) << 5)); }
__host__ __device__ __forceinline__ void stage_rc(int b, int& R, int& C) { const int st = b / 1024, sb = b % 1024, swz = sb ^ (((sb >> 9) & 1) << 5); R = (st >> 1) * 16 + swz / 64; C = (st & 1) * 32 + (swz % 64) / 2; }
__host__ __device__ __forceinline__ int perm32(int rho) { const int n = rho >> 4, i = rho & 15; return 8 * (i >> 2) + 4 * n + (i & 3); }

struct Unit { int pm, pn, z; };
struct Gemm { const bf16_t* A; const bf16_t* Bt; size_t zA, zB; int K; };
template <int NZ> __device__ __forceinline__ const char* selA(const Gemm& g, int z) { if (NZ == 1) return (const char*)g.A; return (const char*)g.A + (size_t)z * g.zA; }
template <int NZ> __device__ __forceinline__ const char* selB(const Gemm& g, int z) { if (NZ == 1) return (const char*)g.Bt; return (const char*)g.Bt + (size_t)z * g.zB; }

template <int NZ> struct StaticOrder {
    int nM, nN, nwg, G, c;
    __device__ void init(int M_, int N_, int G_, int c_) { nM = M_ / BM; nN = N_ / BM; nwg = nM * nN; G = G_; c = c_; }
    __device__ bool next(int i, Unit& u) const {
        const int it = (NZ == 1) ? i : i / NZ; u.z = (NZ == 1) ? 0 : i - it * NZ;
        const long L = (long)it * G + c; if (L >= nwg) return false;
        int wgid = (int)L; { const int q = nwg / NXCD, r = nwg % NXCD, xcd = wgid % NXCD, off = wgid / NXCD; wgid = (xcd < r ? xcd * (q + 1) : r * (q + 1) + (xcd - r) * q) + off; }
        const int nig = WGM * nN, gid = wgid / nig, fm = gid * WGM, gsz = (nM - fm) < WGM ? (nM - fm) : WGM;
        u.pm = fm + ((wgid % nig) % gsz); u.pn = (wgid % nig) / gsz; return true;
    }
};

__device__ __forceinline__ unsigned cvt_pk_bf16(float lo, float hi) { unsigned r; asm volatile("v_cvt_pk_bf16_f32 %0, %1, %2" : "=v"(r) : "v"(lo), "v"(hi)); return r; }


struct EpiProj {
    static constexpr bool PERM = true;
    bf16_t* O; const float* rs;
    __device__ __forceinline__ void operator()(const f32x4 (&acc)[2][2][4][2], const Unit& u, int wr, int wc, int fr, int fq) const {
        const int row0 = u.pm * BM + wr * 64 + fr, col0 = u.pn * BM + wc * 32 + 8 * fq;
#pragma unroll
        for (int ai = 0; ai < 2; ++ai)
#pragma unroll
            for (int m = 0; m < 4; ++m) { const int row = row0 + ai * HALF + m * 16; const float s = rs[row]; bf16_t* rowp = O + (size_t)row * NIN + col0;
#pragma unroll
                for (int bj = 0; bj < 2; ++bj) { const f32x4 v0 = acc[ai][bj][m][0] * s, v1 = acc[ai][bj][m][1] * s;
                    u32x4 w; w.x = cvt_pk_bf16(v0[0], v0[1]); w.y = cvt_pk_bf16(v0[2], v0[3]); w.z = cvt_pk_bf16(v1[0], v1[1]); w.w = cvt_pk_bf16(v1[2], v1[3]);
                    *(u32x4*)(rowp + bj * HALF) = w; } }
    }
};
struct EpiGlu {
    static constexpr bool PERM = true;
    bf16_t* O; const bf16_t* Y; const bf16_t* proj; const float* bias;
    __device__ __forceinline__ void operator()(const f32x4 (&acc)[2][2][4][2], const Unit& u, int wr, int wc, int fr, int fq) const {
        const int row0 = u.pm * BM + wr * 64 + fr, col0 = u.pn * BM + wc * 32 + 8 * fq;
#pragma unroll
        for (int bj = 0; bj < 2; ++bj) { const int col = col0 + bj * HALF; const f32x4 b0 = *(const f32x4*)(bias + col), b1 = *(const f32x4*)(bias + col + 4);
#pragma unroll
            for (int ai = 0; ai < 2; ++ai) {
                u32x4 yv[4], zv[4];
#pragma unroll
                for (int m = 0; m < 4; ++m) { const int row = row0 + ai * HALF + m * 16; yv[m] = *(const u32x4*)(Y + (size_t)row * 1024 + col); zv[m] = *(const u32x4*)(proj + (size_t)row * NIN + C_ZS5 + col); }
#pragma unroll
                for (int m = 0; m < 4; ++m) { const int row = row0 + ai * HALF + m * 16;
                    const f32x4 a0 = acc[ai][bj][m][0] + b0, a1 = acc[ai][bj][m][1] + b1; float o[8]; const float av[8] = {a0[0], a0[1], a0[2], a0[3], a1[0], a1[1], a1[2], a1[3]};
#pragma unroll
                    for (int j = 0; j < 4; ++j) { const unsigned yw = yv[m][j], zw = zv[m][j];
                        o[2 * j] = bflo(yw) * sigmoidf_(av[2 * j]) * siluf_(bflo(zw)); o[2 * j + 1] = bfhi(yw) * sigmoidf_(av[2 * j + 1]) * siluf_(bfhi(zw)); }
                    u32x4 w; w.x = cvt_pk_bf16(o[0], o[1]); w.y = cvt_pk_bf16(o[2], o[3]); w.z = cvt_pk_bf16(o[4], o[5]); w.w = cvt_pk_bf16(o[6], o[7]);
                    *(u32x4*)(O + (size_t)row * 1024 + col) = w; }
                asm volatile("" ::: "memory"); } }
    }
};
struct EpiMerge {
    static constexpr bool PERM = true;
    bf16_t* O; const bf16_t* proj;
    __device__ __forceinline__ void operator()(const f32x4 (&acc)[2][2][4][2], const Unit& u, int wr, int wc, int fr, int fq) const {
        const int row0 = u.pm * BM + wr * 64 + fr, col0 = u.pn * BM + wc * 32 + 8 * fq; const int z = u.z;
        const bf16_t* gp = proj + (size_t)row0 * NIN + C_G + z * 2048 + col0; bf16_t* op = O + (size_t)row0 * DM + col0;
#pragma unroll
        for (int ai = 0; ai < 2; ++ai)
#pragma unroll
            for (int mh = 0; mh < 2; ++mh) {
                u32x4 gv[2][2], tv[2][2];
#pragma unroll
                for (int mm = 0; mm < 2; ++mm)
#pragma unroll
                    for (int bj = 0; bj < 2; ++bj) { const int ro = ai * HALF + (mh * 2 + mm) * 16;
                        gv[mm][bj] = *(const u32x4*)(gp + (size_t)ro * NIN + bj * HALF);
                        tv[mm][bj] = (u32x4){0u, 0u, 0u, 0u}; if (z > 0) tv[mm][bj] = *(const u32x4*)(op + (size_t)ro * DM + bj * HALF); }
#pragma unroll
                for (int mm = 0; mm < 2; ++mm)
#pragma unroll
                    for (int bj = 0; bj < 2; ++bj) { const int m = mh * 2 + mm, ro = ai * HALF + m * 16;
                        const f32x4 a0 = acc[ai][bj][m][0], a1 = acc[ai][bj][m][1]; float o[8]; const float av[8] = {a0[0], a0[1], a0[2], a0[3], a1[0], a1[1], a1[2], a1[3]};
#pragma unroll
                        for (int j = 0; j < 4; ++j) { const unsigned gw = gv[mm][bj][j], tw = tv[mm][bj][j];
                            o[2 * j] = bflo(tw) + sigmoidf_(bflo(gw)) * av[2 * j]; o[2 * j + 1] = bfhi(tw) + sigmoidf_(bfhi(gw)) * av[2 * j + 1]; }
                        u32x4 w; w.x = cvt_pk_bf16(o[0], o[1]); w.y = cvt_pk_bf16(o[2], o[3]); w.z = cvt_pk_bf16(o[4], o[5]); w.w = cvt_pk_bf16(o[6], o[7]);
                        *(u32x4*)(op + (size_t)ro * DM + bj * HALF) = w; }
                asm volatile("" ::: "memory"); }
    }
};
struct EpiOut {
    static constexpr bool PERM = false;
    const float* XinP; const float* XinS; float* Xout; bf16_t* XB; float* rsp;
    __device__ __forceinline__ void operator()(const f32x4 (&acc)[2][2][4][2], const Unit& u, int wr, int wc, int fr, int fq) const {
        const int row0 = u.pm * BM + wr * 64 + fr, col0 = u.pn * BM + wc * 32 + 4 * fq;
#pragma unroll
        for (int ai = 0; ai < 2; ++ai) {
            f32x4 xi[4][2][2];
#pragma unroll
            for (int m = 0; m < 4; ++m) { const int row = row0 + ai * HALF + m * 16; const float* xin = (row < MP ? XinP + (size_t)row * DM : XinS + (size_t)(row - MP) * DM) + col0;
#pragma unroll
                for (int bj = 0; bj < 2; ++bj)
#pragma unroll
                    for (int n = 0; n < 2; ++n) xi[m][bj][n] = *(const f32x4*)(xin + bj * HALF + n * 16); }
#pragma unroll
            for (int m = 0; m < 4; ++m) { const int row = row0 + ai * HALF + m * 16; const size_t off = (size_t)row * DM + col0; float ss = 0.f;
#pragma unroll
                for (int bj = 0; bj < 2; ++bj)
#pragma unroll
                    for (int n = 0; n < 2; ++n) { const f32x4 xo = xi[m][bj][n] + acc[ai][bj][m][n];
                        *(f32x4*)(Xout + off + bj * HALF + n * 16) = xo; if (XB) { u32x2 w; w.x = cvt_pk_bf16(xo[0], xo[1]); w.y = cvt_pk_bf16(xo[2], xo[3]); *(u32x2*)(XB + off + bj * HALF + n * 16) = w; }
                        ss += (xo[0] * xo[0] + xo[1] * xo[1]) + (xo[2] * xo[2] + xo[3] * xo[3]); }
                ss += __shfl_xor(ss, 16); ss += __shfl_xor(ss, 32);
                if (fq == 0) rsp[(size_t)row * 32 + u.pn * 4 + wc] = ss; } }
    }
};

template <class Epi, int NZ = 1, bool ALIGN_EPI = true, bool SP2 = true>
__device__ __forceinline__ void gemm_phase(LAS unsigned char* lds, const int tid, const Gemm g, const StaticOrder<NZ>& S, const Epi& E) {
    const int wid = __builtin_amdgcn_readfirstlane(tid >> 6), lane = tid & 63, wr = wid >> 2, wc = wid & 3, fr = lane & 15, fq = lane >> 4;
    const int K = g.K, nt = K / BK;
    unsigned voffA[2], voffB[2];
#pragma unroll
    for (int i = 0; i < 2; ++i) { int R, C; stage_rc(tid * 16 + i * 8192, R, C); const int Rb = Epi::PERM ? ((R & ~31) + perm32(R & 31)) : R;
        voffA[i] = (unsigned)(R * K + C) * 2u; voffB[i] = (unsigned)(Rb * K + C) * 2u; }
    const size_t kstep = (size_t)(BK * 2);
    const size_t hstep = (size_t)HALF * K * 2;
    const size_t tstep = 2 * hstep;
    const unsigned ldsw = (unsigned)wid * 1024u;
    const int aoff = lds_byte(wr * 64 + fr, fq * 8), boff = lds_byte(wc * 32 + fr, fq * 8);
#define PG8_SA(b, h) (((b) * 2 + (h)) * HTB)
#define PG8_SB(b, h) ((4 + (b) * 2 + (h)) * HTB)
#define PG8_STAGE(bufoff, gbase, voff) do { _Pragma("unroll") for (int _i = 0; _i < 2; ++_i) \
        __builtin_amdgcn_global_load_lds((const unsigned*)((const char*)(gbase) + (voff)[_i]), (LAS unsigned*)(lds + (bufoff) + ldsw + _i * 8192), 16, 0, 0); } while (0)
#define PG8_LDA(dst, b, h) do { _Pragma("unroll") for (int m = 0; m < 4; ++m) _Pragma("unroll") for (int k = 0; k < 2; ++k) dst[m][k] = *(const LAS bf16x8*)(lds + PG8_SA(b, h) + aoff + m * 2048 + k * 1024); } while (0)
#define PG8_LDB(dst, b, h) do { _Pragma("unroll") for (int n = 0; n < 2; ++n) _Pragma("unroll") for (int k = 0; k < 2; ++k) dst[n][k] = *(const LAS bf16x8*)(lds + PG8_SB(b, h) + boff + n * 2048 + k * 1024); } while (0)
#define PG8_MMA(ai, bj, At, Bt) do { __builtin_amdgcn_s_setprio(1); _Pragma("unroll") for (int m = 0; m < 4; ++m) _Pragma("unroll") for (int n = 0; n < 2; ++n) _Pragma("unroll") for (int k = 0; k < 2; ++k) \
        acc[ai][bj][m][n] = __builtin_amdgcn_mfma_f32_16x16x32_bf16(Bt[n][k], At[m][k], acc[ai][bj][m][n], 0, 0, 0); __builtin_amdgcn_s_setprio(0); } while (0)
#define PG8_WAIT_V(n) asm volatile("s_waitcnt vmcnt(" #n ")" ::: "memory")
#define PG8_WAIT_L(n) asm volatile("s_waitcnt lgkmcnt(" #n ")" ::: "memory")
#define PG8_BAR __builtin_amdgcn_s_barrier()
#define PG8_SCHED __builtin_amdgcn_sched_barrier(0)
    Unit cur, nxt; int ui = 0;
    if (!S.next(0, cur)) return;
    f32x4 acc[2][2][4][2];
#pragma unroll
    for (int a = 0; a < 2; ++a)
#pragma unroll
        for (int b = 0; b < 2; ++b)
#pragma unroll
            for (int m = 0; m < 4; ++m)
#pragma unroll
                for (int n = 0; n < 2; ++n) acc[a][b][m][n] = (f32x4){0.f, 0.f, 0.f, 0.f};
    bf16x8 At[4][2], B0[2][2], B1[2][2];
    const char* cA = selA<NZ>(g, cur.z) + (size_t)cur.pm * tstep; const char* cB = selB<NZ>(g, cur.z) + (size_t)cur.pn * tstep;
    if constexpr (SP2) {
        PG8_STAGE(PG8_SB(0, 0), cB, voffB); PG8_STAGE(PG8_SB(0, 1), cB + hstep, voffB); PG8_STAGE(PG8_SA(0, 0), cA, voffA); PG8_STAGE(PG8_SA(0, 1), cA + hstep, voffA);
        if (wr == 1) PG8_BAR;
        PG8_WAIT_V(2); PG8_BAR;
        PG8_STAGE(PG8_SB(1, 0), cB + kstep, voffB); PG8_STAGE(PG8_SA(1, 0), cA + kstep, voffA); PG8_STAGE(PG8_SB(1, 1), cB + hstep + kstep, voffB);
        PG8_WAIT_V(6); PG8_BAR;
    } else {
        PG8_STAGE(PG8_SB(0, 0), cB, voffB); PG8_STAGE(PG8_SA(0, 0), cA, voffA); PG8_STAGE(PG8_SB(0, 1), cB + hstep, voffB); PG8_STAGE(PG8_SA(0, 1), cA + hstep, voffA);
        if (wr == 1) PG8_BAR;
        PG8_WAIT_V(4); PG8_BAR;
        PG8_STAGE(PG8_SB(1, 0), cB + kstep, voffB); PG8_STAGE(PG8_SA(1, 0), cA + kstep, voffA); PG8_STAGE(PG8_SB(1, 1), cB + hstep + kstep, voffB);
        PG8_WAIT_V(6); PG8_BAR;
    }
    for (;;) {
        const bool has_next = S.next(ui + 1, nxt);
        const char* nA = has_next ? selA<NZ>(g, nxt.z) + (size_t)nxt.pm * tstep : cA; const char* nB = has_next ? selB<NZ>(g, nxt.z) + (size_t)nxt.pn * tstep : cB;
        for (int t = 0; t < nt; t += 2) {
            const bool last = (t == nt - 2);
            const char* a1 = cA + (size_t)(t + 1) * kstep;
            const char* a2 = last ? nA : cA + (size_t)(t + 2) * kstep; const char* b2 = last ? nB : cB + (size_t)(t + 2) * kstep;
            const char* a3 = a2 + kstep; const char* b3 = b2 + kstep;
            if constexpr (SP2) {
            PG8_LDB(B0, 0, 0); PG8_LDB(B1, 0, 1); PG8_SCHED; PG8_LDA(At, 0, 0); PG8_STAGE(PG8_SA(1, 1), a1 + hstep, voffA);
            PG8_WAIT_V(8); PG8_WAIT_L(0); PG8_BAR; PG8_MMA(0, 0, At, B0); PG8_MMA(0, 1, At, B1); PG8_BAR; PG8_SCHED;
            PG8_LDA(At, 0, 1); PG8_STAGE(PG8_SB(0, 0), b2, voffB); PG8_STAGE(PG8_SB(0, 1), b2 + hstep, voffB); PG8_STAGE(PG8_SA(0, 0), a2, voffA);
            PG8_WAIT_V(8); PG8_WAIT_L(0); PG8_BAR; PG8_MMA(1, 0, At, B0); PG8_MMA(1, 1, At, B1); PG8_BAR; PG8_SCHED;
            PG8_LDB(B0, 1, 0); PG8_LDB(B1, 1, 1); PG8_SCHED; PG8_LDA(At, 1, 0); PG8_STAGE(PG8_SA(0, 1), a2 + hstep, voffA);
            PG8_WAIT_V(8); PG8_WAIT_L(0); PG8_BAR; PG8_MMA(0, 0, At, B0); PG8_MMA(0, 1, At, B1); PG8_BAR; PG8_SCHED;
            PG8_LDA(At, 1, 1); PG8_STAGE(PG8_SB(1, 0), b3, voffB); PG8_STAGE(PG8_SB(1, 1), b3 + hstep, voffB); PG8_STAGE(PG8_SA(1, 0), a3, voffA);
            PG8_WAIT_V(8); PG8_WAIT_L(0); PG8_BAR; PG8_MMA(1, 0, At, B0); PG8_MMA(1, 1, At, B1); PG8_BAR; PG8_SCHED;
            } else {
            PG8_LDB(B0, 0, 0); PG8_SCHED; PG8_LDA(At, 0, 0); PG8_STAGE(PG8_SA(1, 1), a1 + hstep, voffA);
            PG8_WAIT_L(8); PG8_BAR; PG8_WAIT_L(0); PG8_MMA(0, 0, At, B0); PG8_BAR; PG8_SCHED;
            PG8_LDB(B1, 0, 1); PG8_STAGE(PG8_SB(0, 0), b2, voffB);
            PG8_BAR; PG8_WAIT_L(0); PG8_MMA(0, 1, At, B1); PG8_BAR;
            PG8_LDA(At, 0, 1); PG8_STAGE(PG8_SA(0, 0), a2, voffA);
            PG8_BAR; PG8_WAIT_L(0); PG8_MMA(1, 0, At, B0); PG8_BAR; PG8_SCHED;
            PG8_STAGE(PG8_SB(0, 1), b2 + hstep, voffB);
            PG8_WAIT_V(6); PG8_BAR; PG8_MMA(1, 1, At, B1); PG8_BAR;
            PG8_LDB(B0, 1, 0); PG8_SCHED; PG8_LDA(At, 1, 0); PG8_STAGE(PG8_SA(0, 1), a2 + hstep, voffA);
            PG8_WAIT_L(8); PG8_BAR; PG8_WAIT_L(0); PG8_MMA(0, 0, At, B0); PG8_BAR; PG8_SCHED;
            PG8_LDB(B1, 1, 1); PG8_STAGE(PG8_SB(1, 0), b3, voffB);
            PG8_BAR; PG8_WAIT_L(0); PG8_MMA(0, 1, At, B1); PG8_BAR;
            PG8_LDA(At, 1, 1); PG8_STAGE(PG8_SA(1, 0), a3, voffA);
            PG8_BAR; PG8_WAIT_L(0); PG8_MMA(1, 0, At, B0); PG8_BAR; PG8_SCHED;
            PG8_STAGE(PG8_SB(1, 1), b3 + hstep, voffB);
            PG8_WAIT_V(6); PG8_BAR; PG8_MMA(1, 1, At, B1); PG8_BAR;
            }
        }
        if constexpr (ALIGN_EPI) { if (wr == 0) PG8_BAR; }
        E(acc, cur, wr, wc, fr, fq);
        if (!has_next) break;
#pragma unroll
        for (int a = 0; a < 2; ++a)
#pragma unroll
            for (int b = 0; b < 2; ++b)
#pragma unroll
                for (int m = 0; m < 4; ++m)
#pragma unroll
                    for (int n = 0; n < 2; ++n) acc[a][b][m][n] = (f32x4){0.f, 0.f, 0.f, 0.f};
        cur = nxt; cA = nA; cB = nB; ++ui;
        if constexpr (ALIGN_EPI) { if (wr == 1) PG8_BAR; }
    }
    PG8_WAIT_V(0);
    if constexpr (!ALIGN_EPI) { if (wr == 0) PG8_BAR; }
    PG8_BAR;
#undef PG8_SA
#undef PG8_SB
#undef PG8_STAGE
#undef PG8_LDA
#undef PG8_LDB
#undef PG8_MMA
#undef PG8_WAIT_V
#undef PG8_WAIT_L
#undef PG8_BAR
#undef PG8_SCHED
}
}

constexpr int NWAVES = 8, NTHR = NWAVES * 64;
constexpr int LDS_BYTES = 147456;
constexpr int LDS_MISC_OFF = 143360;

struct Args { const float* in[32]; float* out; unsigned char* ws; int ph_lo, ph_hi; };

struct Ctx {
    LAS unsigned char* lds;
    int tid, lane, wave, vcu, G, gtid, gthreads, gw, ngw;
    const float* const* in; float* out; unsigned char* ws;
};
__device__ __forceinline__ const float* INP_(const float* const* in, int k) { asm volatile("" : "+s"(k)); return in[k]; }
#define INP(k) INP_(C.in, (k))
#define WSP(T, off) ((T*)(C.ws + (off)))
#define cWIN WSP(bf16_t, WS_WIN)
#define cWGLU WSP(bf16_t, WS_WGLU + (size_t)l * WS_LSTRIDE)
#define cWBR WSP(bf16_t, WS_WBR + (size_t)l * WS_LSTRIDE)
#define cWOUT WSP(bf16_t, WS_WOUT + (size_t)l * WS_LSTRIDE)
#define cMERGED WSP(bf16_t, WS_MERGED)
#define cPROJ WSP(bf16_t, WS_PROJ)
#define cYS5 WSP(bf16_t, WS_YS5)
#define cAS5 WSP(bf16_t, WS_AS5)
#define cALRU WSP(bf16_t, WS_ALRU)
#define cARET WSP(bf16_t, WS_ARET)
#define cLRUP WSP(bf16_t, WS_LRUP)
#define cXB ((bf16_t*)(C.out + O_XB))
#define cKV WSP(float, WS_KV)
#define cS5E WSP(float, WS_S5E)
#define cS5HIN WSP(float, WS_S5HIN)
#define cRS WSP(float, WS_MISC + MI_RS)
#define cRSP WSP(float, WS_MISC + MI_RSP)
#define cS5LB WSP(float, WS_MISC + MI_S5LB + (size_t)l * 4 * 4096 * 4)
#define cS5BB WSP(float, WS_MISC + MI_S5BB + (size_t)l * 2 * 65536 * 4)
#define cROPE WSP(float, WS_MISC + MI_ROPE)
#define cLSUM WSP(float, WS_MISC + MI_LSUM)
#define cLHIN WSP(float, WS_MISC + MI_LHIN)
#define cWLRU WSP(bf16_t, WS_MISC + MI_WLRU)

constexpr int TT_PITCH = 257;
__device__ __forceinline__ void transpose_tile(Ctx& C, const float* W, int K, int N, bf16_t* WT, const float* gk, int item) {
    LAS float* scr = (LAS float*)C.lds;
    const int nblk = N / 256, kb = item / nblk, nb = item % nblk, k0 = 64 * kb, n0 = 256 * nb;
    __syncthreads();
    { const int r = C.tid >> 6, c4 = (C.tid & 63) * 4; f32x4 v[8];
#pragma unroll
      for (int i = 0; i < 8; ++i) v[i] = *(const f32x4*)(W + (size_t)(k0 + r + 8 * i) * N + n0 + c4);
#pragma unroll
      for (int i = 0; i < 8; ++i) { const float g = gk ? gk[k0 + r + 8 * i] : 1.0f; LAS float* d = scr + (r + 8 * i) * TT_PITCH + c4; d[0] = v[i][0] * g; d[1] = v[i][1] * g; d[2] = v[i][2] * g; d[3] = v[i][3] * g; } }
    __syncthreads();
    { const int c = C.tid & 7;
#pragma unroll
      for (int j = 0; j < 4; ++j) { const int n = (C.tid >> 3) + 64 * j; const LAS float* s = scr + (8 * c) * TT_PITCH + n;
          u32x4 o; o.x = pk2(s[0 * TT_PITCH], s[1 * TT_PITCH]); o.y = pk2(s[2 * TT_PITCH], s[3 * TT_PITCH]); o.z = pk2(s[4 * TT_PITCH], s[5 * TT_PITCH]); o.w = pk2(s[6 * TT_PITCH], s[7 * TT_PITCH]);
          *(u32x4*)(WT + (size_t)(n0 + n) * K + k0 + 8 * c) = o; } }
}
constexpr int TI_IN = (DM / 64) * (NIN / 256), TI_GLU = (1024 / 64) * (1024 / 256), TI_BR = (1024 / 64) * (DM / 256), TI_OUT = (DM / 64) * (DM / 256), TI_SMALL = TI_GLU + 3 * TI_BR + TI_OUT;
__device__ __forceinline__ void convert_win(Ctx& C, int l) {
    const float* w = INP(8) + (size_t)l * DM * NIN; const float* g = INP(7) + l * DM;
    for (int it = C.vcu; it < TI_IN; it += C.G) transpose_tile(C, w, DM, NIN, cWIN, g, it);
    __syncthreads();
}
__device__ __forceinline__ void convert_small(Ctx& C, int l) {
    const float* in17 = INP(17); const float* in27 = INP(27); const float* in28 = INP(28); const float* in29 = INP(29); const float* in30 = INP(30);
    for (int it = C.vcu; it < TI_SMALL; it += C.G) {
        int r = it;
        if (r < TI_GLU) { transpose_tile(C, in17 + (size_t)l * 1024 * 1024, 1024, 1024, cWGLU, nullptr, r); continue; } r -= TI_GLU;
        if (r < TI_BR) { transpose_tile(C, in27 + (size_t)l * 1024 * DM, 1024, DM, cWBR, nullptr, r); continue; } r -= TI_BR;
        if (r < TI_BR) { transpose_tile(C, in28 + (size_t)l * 1024 * DM, 1024, DM, cWBR + (size_t)DM * 1024, nullptr, r); continue; } r -= TI_BR;
        if (r < TI_BR) { transpose_tile(C, in29 + (size_t)l * 1024 * DM, 1024, DM, cWBR + (size_t)2 * DM * 1024, nullptr, r); continue; } r -= TI_BR;
        transpose_tile(C, in30 + (size_t)l * DM * DM, DM, DM, cWOUT, nullptr, r);
    }
    __syncthreads();
}
__device__ __forceinline__ void s5_params(Ctx& C, int l) {
    const float* in9 = INP(9); const float* in10 = INP(10); const float* in11 = INP(11); const float* in12 = INP(12); const float* in13 = INP(13);
    for (int i = C.gtid; i < S5G * S5P; i += C.gthreads) {
        const int g = i >> 6;
        const float dt = expf(in11[l * S5G + g]), lr = in9[l * 4096 + i], li = in10[l * 4096 + i];
        const float a = lr * dt, b = li * dt, ea = expf(a), cb = cosf(b), sb = sinf(b), sh = sinf(0.5f * b);
        const float lbr = ea * cb, lbi = ea * sb;
        const float nr = expm1f(a) * cb - 2.0f * sh * sh, ni = ea * sb, den = lr * lr + li * li;
        const float cr = (nr * lr + ni * li) / den, ci = (ni * lr - nr * li) / den;
        cS5LB[i] = lbr; cS5LB[4096 + i] = lbi;
        float pr = lbr, pi = lbi;
#pragma unroll
        for (int s = 0; s < 6; ++s) { const float t = pr * pr - pi * pi; pi = 2.0f * pr * pi; pr = t; }
        cS5LB[8192 + i] = pr; cS5LB[12288 + i] = pi;
        const float* bre = in12 + ((size_t)l * 4096 + i) * 16; const float* bim = in13 + ((size_t)l * 4096 + i) * 16;
#pragma unroll
        for (int c = 0; c < 16; ++c) { const float br = bre[c], bi = bim[c]; cS5BB[(size_t)i * 16 + c] = cr * br - ci * bi; cS5BB[65536 + (size_t)i * 16 + c] = cr * bi + ci * br; }
    }
}
__device__ __forceinline__ void phase_prep(Ctx& C, int l) {
    if (l == 0) {
        convert_win(C, 0); convert_small(C, 0); convert_small(C, 1); s5_params(C, 0); s5_params(C, 1);
        { const float* in21 = INP(21); const float* in23 = INP(23);
          for (int i = C.gtid; i < 2 * 8 * 256 * 128; i += C.gthreads) { const int c = i & 127, r = (i >> 7) & 255, ln = i >> 15, gate = r >> 7, d = r & 127;
              cWLRU[i] = (bf16_t)f2bf((gate ? in23 : in21)[(size_t)ln * 16384 + c * 128 + d]); } }
        const float* in0 = INP(0); const float* in1 = INP(1);
        for (int m = C.gw; m < M; m += C.ngw) {
            const float* xr = (m < MP) ? in0 + (size_t)m * DM : in1 + (size_t)(m - MP) * DM;
            float ss = 0.f;
#pragma unroll
            for (int j = 0; j < 8; ++j) { const f32x4 v = *(const f32x4*)(xr + 4 * C.lane + 256 * j); ss += (v[0] * v[0] + v[1] * v[1]) + (v[2] * v[2] + v[3] * v[3]);
                u32x2 w; w.x = pk2(v[0], v[1]); w.y = pk2(v[2], v[3]); *(u32x2*)(cXB + (size_t)m * DM + 4 * C.lane + 256 * j) = w; }
            ss = wave_sum(ss);
            if (C.lane == 0) cRS[m] = 1.0f / sqrtf(ss * (1.0f / DM) + NORM_EPS);
        }
        for (int i = C.gtid; i < 2056 * 64; i += C.gthreads) {
            const int pi_ = i >> 6, j = i & 63; const int pos = pi_ < 2048 ? pi_ : PAST + (pi_ - 2048);
            const float freq = powf(10000.0f, -(float)j / 64.0f); const float ang = (float)pos * freq;
            double r = (double)ang; const double k = rint(r * 0.15915494309189535); r -= k * 6.283185307179586;
            const float rr = (float)r;
            cROPE[i] = cosf(rr); cROPE[2056 * 64 + i] = sinf(rr);
        }
    } else {
        for (int m = C.gtid; m < M; m += C.gthreads) { float ss = 0.f;
#pragma unroll
            for (int j = 0; j < 8; ++j) { const f32x4 v = *(const f32x4*)(cRSP + (size_t)m * 32 + 4 * j); ss += (v[0] + v[1]) + (v[2] + v[3]); }
            cRS[m] = 1.0f / sqrtf(ss * (1.0f / DM) + NORM_EPS); }
    }
}

constexpr int TP = 136;
constexpr int S5_BUP = 132;
struct S5Frags { bf16x8 bb[8]; float lbr, lbi; };
__device__ __forceinline__ void s5_load_bb(Ctx& C, int l, int g, S5Frags& F) {
    const int fr = C.lane & 15, tq = C.lane >> 4;
#pragma unroll
    for (int nt = 0; nt < 8; ++nt) { bf16x8 v = (bf16x8){0, 0, 0, 0, 0, 0, 0, 0};
        if (tq < 2) { const int pp = nt * 16 + fr; const float* s = cS5BB + (pp >= 64 ? 65536 : 0) + ((size_t)(g * 64 + (pp & 63))) * 16 + 8 * tq;
            const f32x4 a = *(const f32x4*)s, b = *(const f32x4*)(s + 4); u32x4 w; w.x = pk2(a[0], a[1]); w.y = pk2(a[2], a[3]); w.z = pk2(b[0], b[1]); w.w = pk2(b[2], b[3]); v = __builtin_bit_cast(bf16x8, w); }
        F.bb[nt] = v; }
    F.lbr = cS5LB[g * 64 + C.lane]; F.lbi = cS5LB[4096 + g * 64 + C.lane];
}
template <bool WRITE_H>
__device__ __forceinline__ void s5_subblock(Ctx& C, const S5Frags& F, size_t row, int g, int nts, LAS float* BUf, LAS bf16_t* Hb, float& hr, float& hi) {
    const int fr = C.lane & 15, tq = C.lane >> 4;
    bf16x8 ua = (bf16x8){0, 0, 0, 0, 0, 0, 0, 0};
    if (tq < 2 && fr < nts) ua = *(const bf16x8*)(cPROJ + (row + fr) * NIN + C_US5 + g * 16 + 8 * tq);
#pragma unroll
    for (int nt = 0; nt < 8; ++nt) { f32x4 d = __builtin_amdgcn_mfma_f32_16x16x32_bf16(ua, F.bb[nt], (f32x4){0.f, 0.f, 0.f, 0.f}, 0, 0, 0);
#pragma unroll
        for (int r = 0; r < 4; ++r) BUf[(tq * 4 + r) * S5_BUP + nt * 16 + fr] = d[r]; }
    LDS_WAIT(); asm volatile("" ::: "memory");
    const int p = C.lane;
#pragma unroll 4
    for (int t = 0; t < nts; ++t) { const float br = BUf[t * S5_BUP + p], bi = BUf[t * S5_BUP + 64 + p];
        const float nr = F.lbr * hr - F.lbi * hi + br, ni = F.lbr * hi + F.lbi * hr + bi; hr = nr; hi = ni;
        if (WRITE_H) { Hb[t * TP + p] = (bf16_t)f2bf(hr); Hb[t * TP + 64 + p] = (bf16_t)f2bf(hi); } }
    LDS_WAIT(); asm volatile("" ::: "memory");
}
__device__ __forceinline__ void s5_pass1(Ctx& C, int l) {
    LAS float* BUf = (LAS float*)(C.lds + C.wave * 12800); LAS bf16_t* Hb = (LAS bf16_t*)(BUf + 16 * S5_BUP);
    for (int it = C.vcu; it < 1024; it += C.G) {
        const int g = it >> 4, k = it & 15, pair = k * 8 + C.wave, b = pair >> 5, j = pair & 31;
        S5Frags F; s5_load_bb(C, l, g, F);
        float hr = 0.f, hi = 0.f; const size_t row0 = (size_t)b * SEQ + j * S5L;
        for (int sb = 0; sb < S5L; sb += 16) s5_subblock<false>(C, F, row0 + sb, g, 16, BUf, Hb, hr, hi);
        const size_t o = ((size_t)(b * S5NCH + j) * 64 + g) * 128 + C.lane; cS5E[o] = hr; cS5E[o + 64] = hi;
    }
}
__device__ __forceinline__ void s5_carry(Ctx& C, int l) {
    for (int i = C.gtid; i < NB * S5G * S5P; i += C.gthreads) {
        const int b = i >> 12, gp = i & 4095, g = gp >> 6, p = gp & 63;
        const float l64r = cS5LB[8192 + gp], l64i = cS5LB[12288 + gp]; float rr = 0.f, ri = 0.f;
        const size_t o0 = ((size_t)(b * S5NCH) * 64 + g) * 128 + p; float er[S5NCH], ei[S5NCH];
#pragma unroll
        for (int j = 0; j < S5NCH; ++j) { er[j] = cS5E[o0 + (size_t)j * 8192]; ei[j] = cS5E[o0 + (size_t)j * 8192 + 64]; }
#pragma unroll
        for (int j = 0; j < S5NCH; ++j) { const size_t o = o0 + (size_t)j * 8192;
            cS5HIN[o] = rr; cS5HIN[o + 64] = ri;
            const float nr = l64r * rr - l64i * ri + er[j], ni = l64r * ri + l64i * rr + ei[j]; rr = nr; ri = ni; }
        C.out[O_S5RP + (size_t)(l * NB + b) * 4096 + gp] = rr; C.out[O_S5IP + (size_t)(l * NB + b) * 4096 + gp] = ri;
    }
}
__device__ __forceinline__ void s5_pass2(Ctx& C, int l) {
    const float* in2 = INP(2); const float* in3 = INP(3); const float* in14 = INP(14); const float* in15 = INP(15); const float* in16 = INP(16);
    LAS float* BUf = (LAS float*)(C.lds + C.wave * 12800); LAS bf16_t* Hb = (LAS bf16_t*)(BUf + 16 * S5_BUP);
    const int fr = C.lane & 15, tq = C.lane >> 4, p = C.lane;
    for (int it = C.vcu; it < 2048; it += C.G) {
        const bool smp = it >= 1024; const int r_ = smp ? it - 1024 : it, g = r_ >> 4, k = r_ & 15, pair = k * 8 + C.wave;
        S5Frags F; s5_load_bb(C, l, g, F);
        bf16x8 ct[4];
#pragma unroll
        for (int ks = 0; ks < 4; ++ks) { const int pp = ks * 32 + tq * 8; const float* s = (pp >= 64 ? in15 : in14) + ((size_t)(l * S5G + g) * 16 + fr) * 64 + (pp & 63); const float sg = pp >= 64 ? -1.f : 1.f;
            const f32x4 a = *(const f32x4*)s * sg, b = *(const f32x4*)(s + 4) * sg; u32x4 w; w.x = pk2(a[0], a[1]); w.y = pk2(a[2], a[3]); w.z = pk2(b[0], b[1]); w.w = pk2(b[2], b[3]); ct[ks] = __builtin_bit_cast(bf16x8, w); }
        float hr, hi; size_t row0; int ntok;
        if (smp) { const size_t o = ((size_t)(l * DB + pair) * 64 + g) * 64 + p; hr = in2[o]; hi = in3[o]; row0 = (size_t)MP + pair * DS; ntok = DS; }
        else { const int b = pair >> 5, j = pair & 31; const size_t o = ((size_t)(b * S5NCH + j) * 64 + g) * 128 + p; hr = cS5HIN[o]; hi = cS5HIN[o + 64]; row0 = (size_t)b * SEQ + j * S5L; ntok = S5L; }
        const float dv = in16[l * 1024 + g * 16 + fr];
        for (int sb = 0; sb < ntok; sb += 16) {
            const int nts = (ntok - sb) < 16 ? (ntok - sb) : 16;
            s5_subblock<true>(C, F, row0 + sb, g, nts, BUf, Hb, hr, hi);
            f32x4 y = (f32x4){0.f, 0.f, 0.f, 0.f};
#pragma unroll
            for (int ks = 0; ks < 4; ++ks) { const bf16x8 a = *(const LAS bf16x8*)(Hb + fr * TP + ks * 32 + tq * 8); y = __builtin_amdgcn_mfma_f32_16x16x32_bf16(a, ct[ks], y, 0, 0, 0); }
#pragma unroll
            for (int r = 0; r < 4; ++r) { const int tok = tq * 4 + r;
                if (tok < nts) { const size_t row = row0 + sb + tok; const float uu = bf2f(cPROJ[row * NIN + C_US5 + g * 16 + fr]);
                    cYS5[row * 1024 + g * 16 + fr] = (bf16_t)f2bf(gelu_tanh(y[r] + dv * uu)); } }
            LDS_WAIT(); asm volatile("" ::: "memory");
        }
        if (smp) { const size_t o = ((size_t)(l * DB + pair) * 64 + g) * 64 + p; C.out[O_S5RS + o] = hr; C.out[O_S5IS + o] = hi; }
    }
}
constexpr int XP = 132;
__device__ __forceinline__ void lru_tiles(Ctx& C, int l) {
    const float* in4 = INP(4); const float* in5 = INP(5); const float* in19 = INP(19); const float* in20 = INP(20); const float* in22 = INP(22); const float* in24 = INP(24); const float* in25 = INP(25);
    LAS bf16_t* WT = (LAS bf16_t*)C.lds;
    LAS bf16_t* XCb = WT + 256 * TP;
    LAS float* XCf = (LAS float*)(C.lds + (256 + 64) * TP * 2);
    constexpr int NTILES = MP / LT + MS / LT;
    int cur_n = -1;
    for (int it = C.vcu; it < NTILES * 8; it += C.G) {
        const int n = it & 7, tile = it >> 3; const bool smp = tile >= MP / LT;
        const size_t row0 = (size_t)tile * LT;
        __syncthreads();
        if (n != cur_n) { cur_n = n; const bf16_t* wsrc = cWLRU + (size_t)(l * 8 + n) * 256 * 128;
#pragma unroll
            for (int i = 0; i < 8; ++i) { const int ch = C.tid + NTHR * i, r = ch >> 4, c8 = (ch & 15) * 8; *(LAS u32x4*)(WT + r * TP + c8) = *(const u32x4*)(wsrc + r * 128 + c8); } }
        { const int tt = C.tid >> 3, cq = C.tid & 7, ch0 = n * 128 + 16 * cq;
          float xc[16];
#pragma unroll
          for (int c = 0; c < 16; ++c) xc[c] = in20[l * 1024 + ch0 + c];
          const int s = smp ? (tt & 7) : ((tile & (LNT - 1)) * LT + tt);
          const int bs = smp ? (tile - MP / LT) * 8 + (tt >> 3) : 0;
#pragma unroll
          for (int k = 0; k < 4; ++k) { const int sr = s - 3 + k; float u[16];
              if (sr >= 0) { const bf16_t* src = cPROJ + (row0 + tt - 3 + k) * NIN + C_ULRU + ch0; const u32x4 v0 = *(const u32x4*)src, v1 = *(const u32x4*)(src + 8);
#pragma unroll
                  for (int j = 0; j < 4; ++j) { u[2 * j] = bflo(v0[j]); u[2 * j + 1] = bfhi(v0[j]); u[8 + 2 * j] = bflo(v1[j]); u[9 + 2 * j] = bfhi(v1[j]); } }
              else if (smp) { const float* src = in5 + ((size_t)(l * DB + bs) * 3 + (sr + 3)) * 1024 + ch0;
#pragma unroll
                  for (int j = 0; j < 4; ++j) { const f32x4 v = *(const f32x4*)(src + 4 * j); u[4 * j] = v[0]; u[4 * j + 1] = v[1]; u[4 * j + 2] = v[2]; u[4 * j + 3] = v[3]; } }
              else {
#pragma unroll
                  for (int c = 0; c < 16; ++c) u[c] = 0.f; }
              const float* cw = in19 + (size_t)(l * 4 + k) * 1024 + ch0;
#pragma unroll
              for (int c = 0; c < 16; ++c) xc[c] += cw[c] * u[c]; }
#pragma unroll
          for (int j = 0; j < 4; ++j) *(LAS f32x4*)(XCf + tt * XP + 16 * cq + 4 * j) = (f32x4){xc[4 * j], xc[4 * j + 1], xc[4 * j + 2], xc[4 * j + 3]};
          u32x4 w0, w1;
#pragma unroll
          for (int j = 0; j < 4; ++j) { w0[j] = pk2(xc[2 * j], xc[2 * j + 1]); w1[j] = pk2(xc[8 + 2 * j], xc[9 + 2 * j]); }
          *(LAS u32x4*)(XCb + tt * TP + 16 * cq) = w0; *(LAS u32x4*)(XCb + tt * TP + 16 * cq + 8) = w1; }
        __syncthreads();
        const int fr = C.lane & 15, tq = C.lane >> 4, d = 16 * C.wave + fr, ch = n * 128 + d;
        f32x4 pa[4], px[4];
#pragma unroll
        for (int mt = 0; mt < 4; ++mt) { pa[mt] = (f32x4){0.f, 0.f, 0.f, 0.f}; px[mt] = (f32x4){0.f, 0.f, 0.f, 0.f}; }
#pragma unroll
        for (int k = 0; k < 4; ++k) { const bf16x8 ba = *(const LAS bf16x8*)(WT + d * TP + k * 32 + tq * 8), bx = *(const LAS bf16x8*)(WT + (128 + d) * TP + k * 32 + tq * 8);
#pragma unroll
            for (int mt = 0; mt < 4; ++mt) { const bf16x8 a = *(const LAS bf16x8*)(XCb + (mt * 16 + fr) * TP + k * 32 + tq * 8);
                pa[mt] = __builtin_amdgcn_mfma_f32_16x16x32_bf16(a, ba, pa[mt], 0, 0, 0); px[mt] = __builtin_amdgcn_mfma_f32_16x16x32_bf16(a, bx, px[mt], 0, 0, 0); } }
        const float ba_ = in22[l * 1024 + ch], bx_ = in24[l * 1024 + ch], sp = log1pf(expf(-in25[l * 1024 + ch]));
#pragma unroll
        for (int mt = 0; mt < 4; ++mt)
#pragma unroll
            for (int r = 0; r < 4; ++r) { const float rg = sigmoidf_(pa[mt][r] + ba_), ig = sigmoidf_(px[mt][r] + bx_), la = -8.0f * rg * sp, a = __expf(la);
                const float xv = XCf[(mt * 16 + tq * 4 + r) * XP + d]; pa[mt][r] = a; px[mt][r] = sqrtf(fmaxf(-expm1f(2.0f * la), 0.f)) * (ig * xv); }
        float RA = 1.f, RB = 0.f;
        if (!smp) {
#pragma unroll
            for (int mt = 0; mt < 4; ++mt) {
                float cA = 1.f, cB = 0.f;
#pragma unroll
                for (int r = 0; r < 4; ++r) { cB = pa[mt][r] * cB + px[mt][r]; cA *= pa[mt][r]; px[mt][r] = cB; pa[mt][r] = cA; }
                float iA = cA, iB = cB;
                { const float pA = __shfl_up(iA, 16), pB = __shfl_up(iB, 16); if (tq >= 1) { iB = iA * pB + iB; iA = iA * pA; } }
                { const float pA = __shfl_up(iA, 32), pB = __shfl_up(iB, 32); if (tq >= 2) { iB = iA * pB + iB; iA = iA * pA; } }
                float eA = __shfl_up(iA, 16), eB = __shfl_up(iB, 16); if (tq == 0) { eA = 1.f; eB = 0.f; }
                const float inB = eA * RB + eB, inA = eA * RA;
#pragma unroll
                for (int r = 0; r < 4; ++r) { px[mt][r] += pa[mt][r] * inB; pa[mt][r] *= inA; }
                const float tA = __shfl(iA, fr + 48), tB = __shfl(iB, fr + 48);
                RB = tA * RB + tB; RA = RA * tA;
            }
            if (tq == 3) { cLSUM[((size_t)tile * 1024 + ch) * 2] = RA; cLSUM[((size_t)tile * 1024 + ch) * 2 + 1] = RB;
                if ((tile & (LNT - 1)) == LNT - 1) { const int b = tile / LNT;
#pragma unroll
                    for (int k = 0; k < 3; ++k) C.out[O_CONVP + ((size_t)(l * NB + b) * 3 + k) * 1024 + ch] = bf2f(cPROJ[(row0 + 61 + k) * NIN + C_ULRU + ch]); } }
        } else {
#pragma unroll
            for (int mt = 0; mt < 4; ++mt) { const int bs = (tile - MP / LT) * 8 + 2 * mt + (tq >> 1);
                float cA = 1.f, cB = 0.f;
#pragma unroll
                for (int r = 0; r < 4; ++r) { cB = pa[mt][r] * cB + px[mt][r]; cA *= pa[mt][r]; px[mt][r] = cB; pa[mt][r] = cA; }
                const float h0 = in4[(size_t)(l * DB + bs) * 1024 + ch];
                const float pA = __shfl_up(cA, 16), pB = __shfl_up(cB, 16);
                const float hin = (tq & 1) ? (pA * h0 + pB) : h0;
#pragma unroll
                for (int r = 0; r < 4; ++r) { px[mt][r] += pa[mt][r] * hin; pa[mt][r] = 0.f; }
                if (tq & 1) { C.out[O_LRUS + (size_t)(l * DB + bs) * 1024 + ch] = px[mt][3];
#pragma unroll
                    for (int k = 0; k < 3; ++k) C.out[O_CONVS + ((size_t)(l * DB + bs) * 3 + k) * 1024 + ch] = bf2f(cPROJ[(row0 + mt * 16 + (tq >> 1) * 8 + 5 + k) * NIN + C_ULRU + ch]); } }
        }
#pragma unroll
        for (int mt = 0; mt < 4; ++mt)
#pragma unroll
            for (int r = 0; r < 4; ++r) { const size_t o = (row0 + mt * 16 + tq * 4 + r) * 1024 + ch; cALRU[o] = (bf16_t)f2bf(px[mt][r]); cLRUP[o] = (bf16_t)f2bf(pa[mt][r]); }
    }
    __syncthreads();
}
__device__ __forceinline__ void lru_carry(Ctx& C, int l) {
    for (int i = C.gtid; i < NB * 1024; i += C.gthreads) { const int b = i >> 10, ch = i & 1023; float run = 0.f; f32x2 pe[LNT];
#pragma unroll
        for (int t = 0; t < LNT; ++t) pe[t] = *(const f32x2*)(cLSUM + ((size_t)(b * LNT + t) * 1024 + ch) * 2);
#pragma unroll
        for (int t = 0; t < LNT; ++t) { cLHIN[(size_t)(b * LNT + t) * 1024 + ch] = run; run = pe[t][0] * run + pe[t][1]; }
        C.out[O_LRUP + (size_t)(l * NB + b) * 1024 + ch] = run; }
}
__device__ __forceinline__ void lru_fin(Ctx& C) {
    for (int i = C.gtid; i < M * 128; i += C.gthreads) { const int row = i >> 7, c8 = (i & 127) * 8;
        const u32x4 hv = *(const u32x4*)(cALRU + (size_t)row * 1024 + c8), pv = *(const u32x4*)(cLRUP + (size_t)row * 1024 + c8), zv = *(const u32x4*)(cPROJ + (size_t)row * NIN + C_ZLRU + c8);
        f32x4 h0 = (f32x4){0.f, 0.f, 0.f, 0.f}, h1 = h0;
        if (row < MP) { const float* hp = cLHIN + (size_t)(row >> 6) * 1024 + c8; h0 = *(const f32x4*)hp; h1 = *(const f32x4*)(hp + 4); }
        u32x4 w;
        const float hh[8] = {h0[0], h0[1], h0[2], h0[3], h1[0], h1[1], h1[2], h1[3]};
#pragma unroll
        for (int j = 0; j < 4; ++j) {
            const float ya = bflo(hv[j]) + bflo(pv[j]) * hh[2 * j], yb = bfhi(hv[j]) + bfhi(pv[j]) * hh[2 * j + 1];
            w[j] = pk2(ya * siluf_(bflo(zv[j])), yb * siluf_(bfhi(zv[j]))); }
        *(u32x4*)(cALRU + (size_t)row * 1024 + c8) = w; }
}

__device__ __forceinline__ void wave_mma_128(const LAS bf16_t* A, int arow0, const LAS bf16_t* Bt, f32x4 (&acc)[8], int lane) {
    const int fr = lane & 15, fq = lane >> 4;
#pragma unroll
    for (int k = 0; k < 4; ++k) { const bf16x8 a = *(const LAS bf16x8*)(A + (arow0 + fr) * TP + k * 32 + fq * 8);
#pragma unroll
        for (int nt = 0; nt < 8; ++nt) { const bf16x8 b = *(const LAS bf16x8*)(Bt + (nt * 16 + fr) * TP + k * 32 + fq * 8);
            acc[nt] = __builtin_amdgcn_mfma_f32_16x16x32_bf16(a, b, acc[nt], 0, 0, 0); } }
}
__device__ __forceinline__ float ret_logg(int h) { return log1pf(-exp2f(-5.0f - (float)h)); }
__device__ __forceinline__ void rope_load(Ctx& C, size_t row, int colb, int posidx, int qd, float (&o1)[16], float (&o2)[16]) {
    const bf16_t* src = cPROJ + row * NIN + colb + 16 * qd;
    const u32x4 a0 = *(const u32x4*)src, a1 = *(const u32x4*)(src + 8), b0 = *(const u32x4*)(src + 64), b1 = *(const u32x4*)(src + 72);
    const float* cs = cROPE + (size_t)posidx * 64 + 16 * qd; const float* sn = cs + 2056 * 64;
    float x1[16], x2[16];
#pragma unroll
    for (int j = 0; j < 4; ++j) { x1[2 * j] = bflo(a0[j]); x1[2 * j + 1] = bfhi(a0[j]); x1[8 + 2 * j] = bflo(a1[j]); x1[9 + 2 * j] = bfhi(a1[j]);
        x2[2 * j] = bflo(b0[j]); x2[2 * j + 1] = bfhi(b0[j]); x2[8 + 2 * j] = bflo(b1[j]); x2[9 + 2 * j] = bfhi(b1[j]); }
#pragma unroll
    for (int j = 0; j < 4; ++j) { const f32x4 c = *(const f32x4*)(cs + 4 * j), s = *(const f32x4*)(sn + 4 * j);
#pragma unroll
        for (int k = 0; k < 4; ++k) { o1[4 * j + k] = x1[4 * j + k] * c[k] - x2[4 * j + k] * s[k]; o2[4 * j + k] = x1[4 * j + k] * s[k] + x2[4 * j + k] * c[k]; } }
}
__device__ __forceinline__ void load_vt(Ctx& C, LAS bf16_t* VT, size_t row0, int h) {
    const int tok = C.tid >> 2, qd = C.tid & 3; const bf16_t* src = cPROJ + (row0 + tok) * NIN + C_V + h * 128 + 32 * qd;
#pragma unroll
    for (int j = 0; j < 4; ++j) { const u32x4 v = *(const u32x4*)(src + 8 * j);
#pragma unroll
        for (int k = 0; k < 4; ++k) { VT[(32 * qd + 8 * j + 2 * k) * TP + tok] = (bf16_t)(v[k] & 0xffffu); VT[(32 * qd + 8 * j + 2 * k + 1) * TP + tok] = (bf16_t)(v[k] >> 16); } }
}
__device__ __forceinline__ void ret_pass1(Ctx& C) {
    LAS bf16_t* KT = (LAS bf16_t*)C.lds; LAS bf16_t* VT = KT + 128 * TP;
    for (int it = C.vcu; it < NB * NH * NCH; it += C.G) {
        const int j = it & 15, bh = it >> 4, h = bh & 7, b = bh >> 3; const size_t row0 = (size_t)b * SEQ + j * RC;
        const float lg = ret_logg(h);
        __syncthreads();
        { const int tok = C.tid >> 2, qd = C.tid & 3; float k1[16], k2[16];
          rope_load(C, row0 + tok, C_K + h * 128, j * RC + tok, qd, k1, k2);
          const float sc = 0.08838834764831845f * expf((float)(RC - 1 - tok) * lg);
#pragma unroll
          for (int i = 0; i < 16; ++i) { KT[(16 * qd + i) * TP + tok] = (bf16_t)f2bf(k1[i] * sc); KT[(64 + 16 * qd + i) * TP + tok] = (bf16_t)f2bf(k2[i] * sc); } }
        load_vt(C, VT, row0, h);
        __syncthreads();
        f32x4 acc[8];
#pragma unroll
        for (int nt = 0; nt < 8; ++nt) acc[nt] = (f32x4){0.f, 0.f, 0.f, 0.f};
        wave_mma_128(KT, 16 * C.wave, VT, acc, C.lane);
        float* dst = cKV + (size_t)it * 16384;
#pragma unroll
        for (int nt = 0; nt < 8; ++nt)
#pragma unroll
            for (int r = 0; r < 4; ++r) dst[(16 * C.wave + (C.lane >> 4) * 4 + r) * 128 + 16 * nt + (C.lane & 15)] = acc[nt][r];
    }
    __syncthreads();
}
__device__ __forceinline__ void ret_prefix(Ctx& C, int l) {
    for (int i = C.gtid; i < NB * NH * 4096; i += C.gthreads) { const int bh = i >> 12, e = (i & 4095) * 4, h = bh & 7;
        const float gc = expf((float)RC * ret_logg(h)); f32x4 run = (f32x4){0.f, 0.f, 0.f, 0.f}; f32x4 t[NCH];
        float* p = cKV + (size_t)bh * NCH * 16384 + e;
#pragma unroll
        for (int j = 0; j < NCH; ++j) t[j] = *(const f32x4*)(p + (size_t)j * 16384);
#pragma unroll
        for (int j = 0; j < NCH; ++j) { *(f32x4*)(p + (size_t)j * 16384) = run; run = gc * run + t[j]; }
        *(f32x4*)(C.out + O_RETP + (size_t)(l * NB * NH + bh) * 16384 + e) = run; }
}
__device__ __forceinline__ void ret_pass2(Ctx& C, int l) {
    const float* in26 = INP(26);
    LAS bf16_t* QS = (LAS bf16_t*)C.lds; LAS bf16_t* KS = QS + 128 * TP; LAS bf16_t* VT = KS + 128 * TP; LAS bf16_t* RT = VT + 128 * TP;
    for (int it = C.vcu; it < NB * NH * NCH; it += C.G) {
        const int j = it & 15, bh = it >> 4, h = bh & 7, b = bh >> 3; const size_t row0 = (size_t)b * SEQ + j * RC;
        const float lg = ret_logg(h);
        __syncthreads();
        { const int tok = C.tid >> 2, qd = C.tid & 3; float a1[16], a2[16];
          rope_load(C, row0 + tok, C_Q + h * 128, j * RC + tok, qd, a1, a2);
#pragma unroll
          for (int i = 0; i < 2; ++i) { u32x4 w, w2;
#pragma unroll
              for (int k = 0; k < 4; ++k) { w[k] = pk2(a1[8 * i + 2 * k], a1[8 * i + 2 * k + 1]); w2[k] = pk2(a2[8 * i + 2 * k], a2[8 * i + 2 * k + 1]); }
              *(LAS u32x4*)(QS + tok * TP + 16 * qd + 8 * i) = w; *(LAS u32x4*)(QS + tok * TP + 64 + 16 * qd + 8 * i) = w2; }
          rope_load(C, row0 + tok, C_K + h * 128, j * RC + tok, qd, a1, a2);
          const float sc = 0.08838834764831845f;
#pragma unroll
          for (int i = 0; i < 2; ++i) { u32x4 w, w2;
#pragma unroll
              for (int k = 0; k < 4; ++k) { w[k] = pk2(a1[8 * i + 2 * k] * sc, a1[8 * i + 2 * k + 1] * sc); w2[k] = pk2(a2[8 * i + 2 * k] * sc, a2[8 * i + 2 * k + 1] * sc); }
              *(LAS u32x4*)(KS + tok * TP + 16 * qd + 8 * i) = w; *(LAS u32x4*)(KS + tok * TP + 64 + 16 * qd + 8 * i) = w2; } }
        load_vt(C, VT, row0, h);
        { const int d = C.tid >> 2, eq = C.tid & 3; const float* src = cKV + (size_t)it * 16384 + d * 128 + 32 * eq;
#pragma unroll
          for (int k = 0; k < 8; ++k) { const f32x4 v = *(const f32x4*)(src + 4 * k);
#pragma unroll
              for (int i = 0; i < 4; ++i) RT[(32 * eq + 4 * k + i) * TP + d] = (bf16_t)f2bf(v[i]); } }
        __syncthreads();
        const int ib = 16 * C.wave + (C.lane >> 4) * 4, jc = C.lane & 15;
        f32x4 acc[8], s[8];
#pragma unroll
        for (int nt = 0; nt < 8; ++nt) { acc[nt] = (f32x4){0.f, 0.f, 0.f, 0.f}; s[nt] = (f32x4){0.f, 0.f, 0.f, 0.f}; }
        wave_mma_128(QS, 16 * C.wave, RT, acc, C.lane);
#pragma unroll
        for (int r = 0; r < 4; ++r) { const float xi = expf((float)(ib + r + 1) * lg);
#pragma unroll
            for (int nt = 0; nt < 8; ++nt) acc[nt][r] *= xi; }
        wave_mma_128(QS, 16 * C.wave, KS, s, C.lane);
        __syncthreads();
#pragma unroll
        for (int nt = 0; nt < 8; ++nt)
#pragma unroll
            for (int r = 0; r < 4; ++r) { const int i = ib + r, jj = 16 * nt + jc; const float dm = (i >= jj) ? expf((float)(i - jj) * lg) : 0.f;
                KS[i * TP + jj] = (bf16_t)f2bf(s[nt][r] * dm); }
        LDS_WAIT(); asm volatile("" ::: "memory");
        wave_mma_128(KS, 16 * C.wave, VT, acc, C.lane);
#pragma unroll
        for (int r = 0; r < 4; ++r) { float s1 = 0.f;
#pragma unroll
            for (int nt = 0; nt < 8; ++nt) s1 += acc[nt][r];
            s1 += __shfl_xor(s1, 1); s1 += __shfl_xor(s1, 2); s1 += __shfl_xor(s1, 4); s1 += __shfl_xor(s1, 8);
            const float mu = s1 * (1.0f / 128.0f); float s2 = 0.f;
#pragma unroll
            for (int nt = 0; nt < 8; ++nt) { const float dlt = acc[nt][r] - mu; s2 += dlt * dlt; }
            s2 += __shfl_xor(s2, 1); s2 += __shfl_xor(s2, 2); s2 += __shfl_xor(s2, 4); s2 += __shfl_xor(s2, 8);
            const float rstd = 1.0f / sqrtf(s2 * (1.0f / 128.0f) + GN_EPS); const size_t row = row0 + ib + r;
#pragma unroll
            for (int nt = 0; nt < 8; ++nt) { const int e = 16 * nt + jc; const float z = bf2f(cPROJ[row * NIN + C_ZRET + h * 128 + e]);
                cARET[row * 1024 + h * 128 + e] = (bf16_t)f2bf((acc[nt][r] - mu) * rstd * in26[l * 1024 + h * 128 + e] * siluf_(z)); } }
    }
    __syncthreads();
}
__device__ __forceinline__ void ret_sample(Ctx& C, int l) {
    const float* in6 = INP(6); const float* in26 = INP(26);
    LAS float* qs = (LAS float*)C.lds; LAS float* ks = qs + 1024; LAS float* vs = ks + 1024; LAS float* SM = vs + 1024; LAS float* OP = SM + 64;
    for (int it = C.vcu; it < DB * NH; it += C.G) {
        const int h = it & 7, bs = it >> 3; const size_t row0 = (size_t)MP + bs * DS; const float lg = ret_logg(h);
        const float* rin = in6 + ((size_t)(l * DB + bs) * NH + h) * 16384; float* rout = C.out + O_RETS + ((size_t)(l * DB + bs) * NH + h) * 16384;
        const int e4 = (C.tid & 31) * 4, d0 = (C.tid >> 5) * 8;
        f32x4 r[8];
#pragma unroll
        for (int dd = 0; dd < 8; ++dd) r[dd] = *(const f32x4*)(rin + (d0 + dd) * 128 + e4);
        __syncthreads();
        { const int tok = C.tid >> 6, x = C.tid & 63; const bf16_t* pr = cPROJ + (row0 + tok) * NIN + h * 128;
          const float c = cROPE[(size_t)(2048 + tok) * 64 + x], sn = cROPE[(size_t)2056 * 64 + (size_t)(2048 + tok) * 64 + x];
          const float q1 = bf2f(pr[C_Q + x]), q2 = bf2f(pr[C_Q + 64 + x]), k1 = bf2f(pr[C_K + x]), k2 = bf2f(pr[C_K + 64 + x]);
          qs[tok * 128 + x] = q1 * c - q2 * sn; qs[tok * 128 + 64 + x] = q1 * sn + q2 * c;
          ks[tok * 128 + x] = (k1 * c - k2 * sn) * 0.08838834764831845f; ks[tok * 128 + 64 + x] = (k1 * sn + k2 * c) * 0.08838834764831845f;
          vs[tok * 128 + x] = bf2f(pr[C_V + x]); vs[tok * 128 + 64 + x] = bf2f(pr[C_V + 64 + x]); }
        __syncthreads();
        { const int ij = C.tid >> 3, part = C.tid & 7, i = ij >> 3, jj = ij & 7; float a = 0.f;
#pragma unroll
          for (int dq = 0; dq < 4; ++dq) { const f32x4 qa = *(const LAS f32x4*)(qs + i * 128 + part * 16 + 4 * dq), kb = *(const LAS f32x4*)(ks + jj * 128 + part * 16 + 4 * dq); a += (qa[0] * kb[0] + qa[1] * kb[1]) + (qa[2] * kb[2] + qa[3] * kb[3]); }
          a += __shfl_xor(a, 1); a += __shfl_xor(a, 2); a += __shfl_xor(a, 4);
          if (part == 0) SM[ij] = a; }
        { f32x4 v4[8], oacc[8]; float gz[8]; const float g8 = expf(8.0f * lg);
#pragma unroll
          for (int t = 0; t < 8; ++t) { v4[t] = *(const LAS f32x4*)(vs + t * 128 + e4); oacc[t] = (f32x4){0.f, 0.f, 0.f, 0.f}; gz[t] = expf((float)(7 - t) * lg); }
#pragma unroll
          for (int dd = 0; dd < 8; ++dd) { const int d = d0 + dd; f32x4 rn = g8 * r[dd];
#pragma unroll
              for (int t = 0; t < 8; ++t) { oacc[t] += qs[t * 128 + d] * r[dd]; rn += (gz[t] * ks[t * 128 + d]) * v4[t]; }
              *(f32x4*)(rout + d * 128 + e4) = rn; }
#pragma unroll
          for (int t = 0; t < 8; ++t) {
#pragma unroll
              for (int k = 0; k < 4; ++k) oacc[t][k] += __shfl_xor(oacc[t][k], 32);
              if (C.lane < 32) *(LAS f32x4*)(OP + (C.wave * 8 + t) * 128 + e4) = oacc[t]; } }
        __syncthreads();
        { const int tok = C.tid >> 6, x = C.tid & 63; float o[2];
#pragma unroll
          for (int hh = 0; hh < 2; ++hh) { const int e = x + 64 * hh; float a = 0.f;
#pragma unroll
              for (int w = 0; w < 8; ++w) a += OP[(w * 8 + tok) * 128 + e];
              a *= expf((float)(tok + 1) * lg);
              for (int jj = 0; jj <= tok; ++jj) a += expf((float)(tok - jj) * lg) * SM[tok * 8 + jj] * vs[jj * 128 + e];
              o[hh] = a; }
          const float mu = wave_sum(o[0] + o[1]) * (1.0f / 128.0f); const float dd0 = o[0] - mu, dd1 = o[1] - mu;
          const float rstd = 1.0f / sqrtf(wave_sum(dd0 * dd0 + dd1 * dd1) * (1.0f / 128.0f) + GN_EPS);
          const bf16_t* pr = cPROJ + (row0 + tok) * NIN + C_ZRET + h * 128; bf16_t* dst = cARET + (row0 + tok) * 1024 + h * 128; const float* gn = in26 + l * 1024 + h * 128;
          dst[x] = (bf16_t)f2bf(dd0 * rstd * gn[x] * siluf_(bf2f(pr[x]))); dst[x + 64] = (bf16_t)f2bf(dd1 * rstd * gn[x + 64] * siluf_(bf2f(pr[x + 64]))); }
    }
    __syncthreads();
}

__device__ __forceinline__ void phase_final(Ctx& C) {
    const float* in31 = INP(31);
    for (int m = C.gw; m < M; m += C.ngw) { float ss = 0.f;
        if (C.lane < 32) ss = cRSP[(size_t)m * 32 + C.lane];
        ss = wave_sum(ss); const float rs = 1.0f / sqrtf(ss * (1.0f / DM) + NORM_EPS);
        float* xr = C.out + (size_t)m * DM;
#pragma unroll
        for (int j = 0; j < 8; ++j) { const int c = 4 * C.lane + 256 * j; const f32x4 v = *(const f32x4*)(xr + c), g = *(const f32x4*)(in31 + c); *(f32x4*)(xr + c) = v * rs * g; } }
}


#define XB_TMO      128
#define XB_XCNT(j)  (256  + 64 * (j))
#define XB_XSUB(j)  (1280 + 64 * (j))
#define XB_XGEN(j)  (2304 + 64 * (j))
#define XB_TOP      3328
#define XB_TOPGEN   3392
#define XCD_BAR_WORDS 3456
#define XB_SPIN_CAP (1u << 20)
__device__ __forceinline__ unsigned xb_ld(unsigned* p)              { return __hip_atomic_load(p, __ATOMIC_RELAXED, __HIP_MEMORY_SCOPE_AGENT); }
__device__ __forceinline__ unsigned xb_add(unsigned* p, unsigned v) { return __hip_atomic_fetch_add(p, v, __ATOMIC_RELAXED, __HIP_MEMORY_SCOPE_AGENT); }
__device__ __forceinline__ unsigned xb_xcc_id() { return (unsigned)__builtin_amdgcn_s_getreg((3 << 11) | 20) & 0xFu; }
#define XB_SPIN(cond, bar) do { unsigned _sp = 0; while (cond) { __builtin_amdgcn_s_sleep(1); \
    if ((++_sp & 255u) == 0u) { if (xb_ld(&(bar)[XB_TMO])) break; if (_sp > XB_SPIN_CAP) { atomicAdd(&(bar)[XB_TMO], 1u); break; } } } } while (0)
struct XcdBarrier { unsigned* bar; unsigned x; volatile LAS unsigned* st; };
__device__ __forceinline__ XcdBarrier xcd_barrier_post(unsigned* bar, volatile LAS unsigned* st) {
    XcdBarrier b; b.bar = bar; b.x = xb_xcc_id(); b.st = st;
    if (threadIdx.x == 0) (void)xb_add(&bar[XB_XCNT(b.x)], 1u);
    return b;
}
__device__ __forceinline__ void xcd_barrier_complete(unsigned* bar, unsigned x, unsigned& nloc, unsigned& nx) {
    const unsigned G = gridDim.x * gridDim.y * gridDim.z;
    unsigned sum, cnt, mine, sp = 0u;
    for (;;) {
        sum = 0u; cnt = 0u; mine = 0u;
#pragma unroll
        for (unsigned j = 0; j < 16; ++j) { const unsigned c = xb_ld(&bar[XB_XCNT(j)]); sum += c; cnt += (c > 0u) ? 1u : 0u; mine = (j == x) ? c : mine; }
        if (sum == G) break;
        __builtin_amdgcn_s_sleep(1);
        if ((++sp & 255u) == 0u) { if (xb_ld(&bar[XB_TMO])) break; if (sp > XB_SPIN_CAP) { atomicAdd(&bar[XB_TMO], 1u); break; } }
    }
    nloc = mine > 0u ? mine : 1u; nx = cnt > 0u ? cnt : 1u;
}
__device__ __forceinline__ void xcd_barrier(const XcdBarrier& b) {
    asm volatile("s_waitcnt vmcnt(0)" ::: "memory");
    __syncthreads();
    if (threadIdx.x == 0) {
        unsigned* bar = b.bar;
        __builtin_amdgcn_s_waitcnt(0);
        unsigned nloc = b.st[0], nx = b.st[1];
        if (nloc == 0u) { xcd_barrier_complete(bar, b.x, nloc, nx); b.st[0] = nloc; b.st[1] = nx; }
        const unsigned old = xb_add(&bar[XB_XSUB(b.x)], 1u);
        const unsigned gen = old / nloc;
        if (old + 1u == (gen + 1u) * nloc) {
            __builtin_amdgcn_fence(__ATOMIC_RELEASE, "agent");
            asm volatile("s_waitcnt vmcnt(0)" ::: "memory");
            const unsigned og = xb_add(&bar[XB_TOP], 1u);
            const unsigned tg = og / nx;
            if (og + 1u == (tg + 1u) * nx) xb_add(&bar[XB_TOPGEN], 1u);
            else XB_SPIN(xb_ld(&bar[XB_TOPGEN]) == tg, bar);
            __builtin_amdgcn_fence(__ATOMIC_ACQUIRE, "agent");
            xb_add(&bar[XB_XGEN(b.x)], 1u);
            asm volatile("s_waitcnt vmcnt(0)" ::: "memory");
        } else {
            XB_SPIN(xb_ld(&bar[XB_XGEN(b.x)]) == gen, bar);
            __builtin_amdgcn_fence(__ATOMIC_ACQUIRE, "agent");
            asm volatile("s_waitcnt vmcnt(0)" ::: "memory");
        }
    }
    __syncthreads();
}

constexpr int PH_PER_LAYER = 8, N_PHASES = 2 * PH_PER_LAYER + 1;
__global__ void __launch_bounds__(NTHR, 2) fwd_kernel(Args args) {
    extern __shared__ __attribute__((aligned(16))) unsigned char lds_raw[];
    Ctx C;
    C.lds = (LAS unsigned char*)lds_raw;
    C.in = args.in;
    { volatile LAS unsigned* misc = (volatile LAS unsigned*)(C.lds + LDS_MISC_OFF); if (threadIdx.x < 32) misc[threadIdx.x] = 0u; }
    __syncthreads();
    XcdBarrier xbar = xcd_barrier_post((unsigned*)(args.ws + WS_CTL) + 4096, (volatile LAS unsigned*)(C.lds + LDS_MISC_OFF) + 8);
#ifdef TSEL
    unsigned long long t_acc = 0ull;
#endif
    for (int ph = args.ph_lo; ph < args.ph_hi; ++ph) {
#ifdef TSEL
        const unsigned long long t_ph0 = __builtin_amdgcn_s_memrealtime();
#endif
        int bid = (int)blockIdx.x, tidv = (int)threadIdx.x, gdim = (int)gridDim.x; asm volatile("" : "+s"(bid), "+v"(tidv), "+s"(gdim));
        C.tid = tidv; C.lane = C.tid & 63; C.wave = __builtin_amdgcn_readfirstlane(C.tid >> 6);
        C.G = gdim; C.vcu = (C.G % 8 == 0) ? (bid % 8) * (C.G / 8) + bid / 8 : bid;
        C.gtid = C.vcu * NTHR + C.tid; C.gthreads = C.G * NTHR; C.gw = C.vcu * NWAVES + C.wave; C.ngw = C.G * NWAVES;
        { unsigned long long w = (unsigned long long)args.ws, o = (unsigned long long)args.out; asm volatile("" : "+s"(w), "+s"(o));
          C.ws = (unsigned char*)w; C.out = (float*)o; }
        if (ph == N_PHASES - 1) { phase_final(C); }
        else {
            const int l = ph / PH_PER_LAYER, k = ph % PH_PER_LAYER;
            if (k == 0) { if (PHMASK & 1) phase_prep(C, l); }
            else if (k == 1) { if (PHMASK & 2) { pg8::Gemm g{}; g.A = cXB; g.Bt = cWIN; g.K = DM; pg8::StaticOrder<1> S; S.init(M, NIN, C.G, bid);
                pg8::EpiProj E{cPROJ, cRS}; pg8::gemm_phase<pg8::EpiProj>(C.lds, C.tid, g, S, E); } }
            else if (k == 2) { if (PHMASK & 4) s5_pass1(C, l); if (PHMASK & 8) lru_tiles(C, l); if (PHMASK & 16) ret_pass1(C); if (PHMASK & 32) ret_sample(C, l); }
            else if (k == 3) { if (PHMASK & 64) { s5_carry(C, l); lru_carry(C, l); ret_prefix(C, l); if (l == 0) convert_win(C, 1); } }
            else if (k == 4) { if (PHMASK & 128) s5_pass2(C, l); if (PHMASK & 256) lru_fin(C); if (PHMASK & 512) ret_pass2(C, l); }
            else if (k == 5) { if (PHMASK & 1024) { pg8::Gemm g{}; g.A = cYS5; g.Bt = cWGLU; g.K = 1024; pg8::StaticOrder<1> S; S.init(M, 1024, C.G, bid);
                pg8::EpiGlu E{cAS5, cYS5, cPROJ, INP(18) + l * 1024}; pg8::gemm_phase<pg8::EpiGlu>(C.lds, C.tid, g, S, E); } }
            else if (k == 6) { if (PHMASK & 2048) { pg8::Gemm g{}; g.A = cAS5; g.Bt = cWBR; g.zA = WS_ALRU - WS_AS5; g.zB = (size_t)DM * 1024 * 2; g.K = 1024;
                pg8::StaticOrder<3> S; S.init(M, DM, C.G, bid);
                pg8::EpiMerge E{cMERGED, cPROJ}; pg8::gemm_phase<pg8::EpiMerge, 3>(C.lds, C.tid, g, S, E); } }
            else { if (PHMASK & 4096) { pg8::Gemm g{}; g.A = cMERGED; g.Bt = cWOUT; g.K = DM; pg8::StaticOrder<1> S; S.init(M, DM, C.G, bid);
                const float* x0 = INP(0); const float* x1 = INP(1); pg8::EpiOut E{l == 0 ? x0 : C.out, l == 0 ? x1 : C.out + (size_t)MP * DM, C.out, l == 0 ? cXB : (bf16_t*)nullptr, cRSP}; pg8::gemm_phase<pg8::EpiOut>(C.lds, C.tid, g, S, E); } }
        }
        if (ph + 1 < args.ph_hi) { if (ph == args.ph_lo) cg::this_grid().sync(); else xcd_barrier(xbar); }
#ifdef TSEL
        { const int kk = (ph == N_PHASES - 1) ? 8 : ph % PH_PER_LAYER; if ((TSEL >> kk) & 1) t_acc += __builtin_amdgcn_s_memrealtime() - t_ph0; }
#endif
    }
#ifdef TSEL
    if (blockIdx.x == 0 && threadIdx.x == 0) { const unsigned long long t_end = __builtin_amdgcn_s_memrealtime(); while (__builtin_amdgcn_s_memrealtime() - t_end < 3ull * t_acc) __builtin_amdgcn_s_sleep(16); }
#endif
}


#ifdef PROBE_TABLE
__global__ void probe_kernel(float* out) {
    const float tab[12][2] = PROBE_TABLE;
    const size_t offs[13] = {O_YP, O_YS, O_S5RP, O_S5IP, O_LRUP, O_CONVP, O_RETP, O_S5RS, O_S5IS, O_LRUS, O_CONVS, O_RETS, O_END};
    for (int o = 0; o < 12; ++o) { const size_t n = offs[o + 1] - offs[o], half = n / 2;
        for (size_t i = (size_t)blockIdx.x * blockDim.x + threadIdx.x; i < n; i += (size_t)gridDim.x * blockDim.x) { const float s = (o < 2) ? tab[o][0] : tab[o][i >= half];
            out[offs[o] + i] = (s == 0.f) ? 0.f : out[offs[o] + i] * s; } }
}
#endif

extern "C" void kernel_launch(void* const* d_in, const int* in_sizes, int n_in, void* d_out, int out_size, void* d_ws, size_t ws_size, hipStream_t stream) {
    static int grid = 0;
    if (grid == 0) {
        if (n_in != 32 || out_size != (int)O_END || ws_size < WS_END) { fprintf(stderr, "kernel_launch: unexpected shapes: n_in %d out %d ws %zu (need %zu)\n", n_in, out_size, ws_size, (size_t)WS_END); grid = -1; return; }
        int dev = 0, cus = 0, per_cu = 0;
        if (hipGetDevice(&dev) != hipSuccess || hipDeviceGetAttribute(&cus, hipDeviceAttributeMultiprocessorCount, dev) != hipSuccess) { grid = -1; return; }
        if (hipFuncSetAttribute((const void*)fwd_kernel, hipFuncAttributeMaxDynamicSharedMemorySize, LDS_BYTES) != hipSuccess) { fprintf(stderr, "kernel_launch: hipFuncSetAttribute failed\n"); grid = -1; return; }
        if (hipOccupancyMaxActiveBlocksPerMultiprocessor(&per_cu, (const void*)fwd_kernel, NTHR, LDS_BYTES) != hipSuccess || per_cu < 1) { fprintf(stderr, "kernel_launch: occupancy query says %d\n", per_cu); per_cu = 1; }
        (void)hipGetLastError();
        grid = cus;
    }
    if (grid < 0) return;
    (void)hipMemsetAsync((char*)d_ws + WS_CTL, 0, CTL_ZERO_BYTES, stream);
    Args a{};
    for (int i = 0; i < 32; ++i) a.in[i] = (const float*)d_in[i];
    a.out = (float*)d_out; a.ws = (unsigned char*)d_ws;
#if MK_N_LAUNCHES == 1
    a.ph_lo = 0; a.ph_hi = N_PHASES;
    void* kargs[] = {&a};
    hipError_t e = hipLaunchCooperativeKernel((const void*)fwd_kernel, dim3(grid), dim3(NTHR), kargs, LDS_BYTES, stream);
    if (e != hipSuccess) fprintf(stderr, "kernel_launch: cooperative launch failed: %s (grid %d)\n", hipGetErrorString(e), grid);
#else
    for (int ph = 0; ph < N_PHASES; ++ph) { a.ph_lo = ph; a.ph_hi = ph + 1; hipLaunchKernelGGL(fwd_kernel, dim3(grid), dim3(NTHR), LDS_BYTES, stream, a); }
#endif
#ifdef PROBE_TABLE
    hipLaunchKernelGGL(probe_kernel, dim3(2048), dim3(256), 0, stream, (float*)d_out);
#endif
}
```

```cpp
#include <hip/hip_runtime.h>
#include <hip/hip_cooperative_groups.h>
#include <cstdio>
#include <cstdint>
namespace cg = cooperative_groups;

#ifndef PHMASK
#define PHMASK 0xFFFF
#endif
#ifndef MK_N_LAUNCHES
#define MK_N_LAUNCHES 1
#endif

#define LAS __attribute__((address_space(3)))
#define GAS __attribute__((address_space(1)))
typedef unsigned short bf16_t;
typedef short bf16x8 __attribute__((ext_vector_type(8)));
typedef float f32x4 __attribute__((ext_vector_type(4)));
typedef float f32x2 __attribute__((ext_vector_type(2)));
typedef unsigned u32x4 __attribute__((ext_vector_type(4)));
typedef unsigned u32x2 __attribute__((ext_vector_type(2)));

constexpr int DM = 2048, NB = 4, SEQ = 2048, DEPTH = 2, DB = 128, DS = 8, PAST = 16384;
constexpr int MP = NB * SEQ, MS = DB * DS, M = MP + MS;
constexpr int NIN = 14336;
constexpr int C_US5 = 0, C_ZS5 = 1024, C_ULRU = 2048, C_ZLRU = 3072, C_Q = 4096, C_K = 5120, C_V = 6144, C_ZRET = 7168, C_G = 8192;
constexpr int NH = 8, DK = 128, DV = 128, RC = 128, NCH = SEQ / RC;
constexpr int S5G = 64, S5P = 64, S5C = 16;
constexpr int S5L = 64, S5NCH = SEQ / S5L;
constexpr int LT = 64, LNT = SEQ / LT;
constexpr float NORM_EPS = 1e-6f, GN_EPS = 1e-5f;

constexpr size_t O_YP = 0, O_YS = 16777216, O_S5RP = 18874368, O_S5IP = 18907136, O_LRUP = 18939904, O_CONVP = 18948096, O_RETP = 18972672,
                 O_S5RS = 20021248, O_S5IS = 21069824, O_LRUS = 22118400, O_CONVS = 22380544, O_RETS = 23166976, O_END = 56721408;
constexpr size_t O_XB = O_RETS + 16777216;

constexpr size_t MiB = 1u << 20;
constexpr size_t WS_CTL = 0, CTL_ZERO_BYTES = 1 * MiB;
constexpr size_t WS_WIN = 1 * MiB, WS_WGLU = 57 * MiB, WS_WBR = 59 * MiB, WS_WOUT = 71 * MiB, WS_MERGED = 79 * MiB, WS_PROJ = 115 * MiB,
                 WS_YS5 = 367 * MiB, WS_AS5 = 385 * MiB, WS_ALRU = 403 * MiB, WS_ARET = 421 * MiB, WS_KV = 439 * MiB, WS_S5E = 471 * MiB, WS_S5HIN = 475 * MiB,
                 WS_MISC = 479 * MiB, WS_SMALL1 = 487 * MiB, WS_END = 509 * MiB;
constexpr size_t WS_LSTRIDE = WS_SMALL1 - WS_WGLU;
static_assert(WS_ALRU - WS_AS5 == WS_ARET - WS_ALRU, "branch operands equally spaced");
constexpr size_t WS_LRUP = WS_AS5;
constexpr size_t MI_RS = 0;
constexpr size_t MI_RSP = 64 * 1024;
constexpr size_t MI_S5LB = MI_RSP + (size_t)M * 32 * 4;
constexpr size_t MI_S5BB = MI_S5LB + 2 * 4 * 4096 * 4;
constexpr size_t MI_ROPE = MI_S5BB + 2 * 2 * 65536 * 4;
constexpr size_t MI_LSUM = MI_ROPE + 2 * 2056 * 64 * 4;
constexpr size_t MI_LHIN = MI_LSUM + (size_t)NB * LNT * 1024 * 2 * 4;
constexpr size_t MI_WLRU = MI_LHIN + (size_t)NB * LNT * 1024 * 4;
constexpr size_t MI_END = MI_WLRU + (size_t)2 * 8 * 256 * 128 * 2;
static_assert(MI_END <= 8 * MiB, "misc region");

__device__ __forceinline__ float bf2f(unsigned b) { return __uint_as_float(b << 16); }
__device__ __forceinline__ unsigned f2bf(float f) { unsigned u = __float_as_uint(f); return (u + 0x7fffu + ((u >> 16) & 1u)) >> 16; }
__device__ __forceinline__ unsigned pk2(float lo, float hi) { return f2bf(lo) | (f2bf(hi) << 16); }
__device__ __forceinline__ float bflo(unsigned w) { return __uint_as_float(w << 16); }
__device__ __forceinline__ float bfhi(unsigned w) { return __uint_as_float(w & 0xffff0000u); }
__device__ __forceinline__ float sigmoidf_(float x) { return 1.0f / (1.0f + __expf(-x)); }
__device__ __forceinline__ float siluf_(float x) { return x / (1.0f + __expf(-x)); }
__device__ __forceinline__ float gelu_tanh(float x) { const float u = 1.5957691216f * (x + 0.044715f * x * x * x); return x / (1.0f + __expf(-u)); }
__device__ __forceinline__ float wave_sum(float v) {
#pragma unroll
    for (int o = 1; o < 64; o <<= 1) v += __shfl_xor(v, o);
    return v;
}
#define LDS_WAIT() asm volatile("s_waitcnt lgkmcnt(0)" ::: "memory")
#define VM_WAIT() asm volatile("s_waitcnt vmcnt(0)" ::: "memory")

namespace pg8 {
constexpr int BM = 256, BK = 64, HALF = 128, HTB = HALF * BK * 2, STAGE_BYTES = 8 * HTB, NXCD = 8, WGM = 8;
__host__ __device__ __forceinline__ int lds_byte(int r, int c) { const int st = (r >> 4) * 2 + (c >> 5), rr = r & 15, cc = c & 31, ob = rr * 64 + cc * 2; return st * 1024 + (ob ^ (((ob >> 9) & 1) << 5)); }
__host__ __device__ __forceinline__ void stage_rc(int b, int& R, int& C) { const int st = b / 1024, sb = b % 1024, swz = sb ^ (((sb >> 9) & 1) << 5); R = (st >> 1) * 16 + swz / 64; C = (st & 1) * 32 + (swz % 64) / 2; }
__host__ __device__ __forceinline__ int perm32(int rho) { const int n = rho >> 4, i = rho & 15; return 8 * (i >> 2) + 4 * n + (i & 3); }

struct Unit { int pm, pn, z; };
struct Gemm { const bf16_t* A; const bf16_t* Bt; size_t zA, zB; int K; };
template <int NZ> __device__ __forceinline__ const char* selA(const Gemm& g, int z) { if (NZ == 1) return (const char*)g.A; return (const char*)g.A + (size_t)z * g.zA; }
template <int NZ> __device__ __forceinline__ const char* selB(const Gemm& g, int z) { if (NZ == 1) return (const char*)g.Bt; return (const char*)g.Bt + (size_t)z * g.zB; }

template <int NZ> struct StaticOrder {
    int nM, nN, nwg, G, c;
    __device__ void init(int M_, int N_, int G_, int c_) { nM = M_ / BM; nN = N_ / BM; nwg = nM * nN; G = G_; c = c_; }
    __device__ bool next(int i, Unit& u) const {
        const int it = (NZ == 1) ? i : i / NZ; u.z = (NZ == 1) ? 0 : i - it * NZ;
        const long L = (long)it * G + c; if (L >= nwg) return false;
        int wgid = (int)L; { const int q = nwg / NXCD, r = nwg % NXCD, xcd = wgid % NXCD, off = wgid / NXCD; wgid = (xcd < r ? xcd * (q + 1) : r * (q + 1) + (xcd - r) * q) + off; }
        const int nig = WGM * nN, gid = wgid / nig, fm = gid * WGM, gsz = (nM - fm) < WGM ? (nM - fm) : WGM;
        u.pm = fm + ((wgid % nig) % gsz); u.pn = (wgid % nig) / gsz; return true;
    }
};

__device__ __forceinline__ unsigned cvt_pk_bf16(float lo, float hi) { unsigned r; asm volatile("v_cvt_pk_bf16_f32 %0, %1, %2" : "=v"(r) : "v"(lo), "v"(hi)); return r; }


struct EpiProj {
    static constexpr bool PERM = true;
    bf16_t* O; const float* rs;
    __device__ __forceinline__ void operator()(const f32x4 (&acc)[2][2][4][2], const Unit& u, int wr, int wc, int fr, int fq) const {
        const int row0 = u.pm * BM + wr * 64 + fr, col0 = u.pn * BM + wc * 32 + 8 * fq;
#pragma unroll
        for (int ai = 0; ai < 2; ++ai)
#pragma unroll
            for (int m = 0; m < 4; ++m) { const int row = row0 + ai * HALF + m * 16; const float s = rs[row]; bf16_t* rowp = O + (size_t)row * NIN + col0;
#pragma unroll
                for (int bj = 0; bj < 2; ++bj) { const f32x4 v0 = acc[ai][bj][m][0] * s, v1 = acc[ai][bj][m][1] * s;
                    u32x4 w; w.x = cvt_pk_bf16(v0[0], v0[1]); w.y = cvt_pk_bf16(v0[2], v0[3]); w.z = cvt_pk_bf16(v1[0], v1[1]); w.w = cvt_pk_bf16(v1[2], v1[3]);
                    *(u32x4*)(rowp + bj * HALF) = w; } }
    }
};
struct EpiGlu {
    static constexpr bool PERM = true;
    bf16_t* O; const bf16_t* Y; const bf16_t* proj; const float* bias;
    __device__ __forceinline__ void operator()(const f32x4 (&acc)[2][2][4][2], const Unit& u, int wr, int wc, int fr, int fq) const {
        const int row0 = u.pm * BM + wr * 64 + fr, col0 = u.pn * BM + wc * 32 + 8 * fq;
#pragma unroll
        for (int bj = 0; bj < 2; ++bj) { const int col = col0 + bj * HALF; const f32x4 b0 = *(const f32x4*)(bias + col), b1 = *(const f32x4*)(bias + col + 4);
#pragma unroll
            for (int ai = 0; ai < 2; ++ai) {
                u32x4 yv[4], zv[4];
#pragma unroll
                for (int m = 0; m < 4; ++m) { const int row = row0 + ai * HALF + m * 16; yv[m] = *(const u32x4*)(Y + (size_t)row * 1024 + col); zv[m] = *(const u32x4*)(proj + (size_t)row * NIN + C_ZS5 + col); }
#pragma unroll
                for (int m = 0; m < 4; ++m) { const int row = row0 + ai * HALF + m * 16;
                    const f32x4 a0 = acc[ai][bj][m][0] + b0, a1 = acc[ai][bj][m][1] + b1; float o[8]; const float av[8] = {a0[0], a0[1], a0[2], a0[3], a1[0], a1[1], a1[2], a1[3]};
#pragma unroll
                    for (int j = 0; j < 4; ++j) { const unsigned yw = yv[m][j], zw = zv[m][j];
                        o[2 * j] = bflo(yw) * sigmoidf_(av[2 * j]) * siluf_(bflo(zw)); o[2 * j + 1] = bfhi(yw) * sigmoidf_(av[2 * j + 1]) * siluf_(bfhi(zw)); }
                    u32x4 w; w.x = cvt_pk_bf16(o[0], o[1]); w.y = cvt_pk_bf16(o[2], o[3]); w.z = cvt_pk_bf16(o[4], o[5]); w.w = cvt_pk_bf16(o[6], o[7]);
                    *(u32x4*)(O + (size_t)row * 1024 + col) = w; }
                asm volatile("" ::: "memory"); } }
    }
};
struct EpiMerge {
    static constexpr bool PERM = true;
    bf16_t* O; const bf16_t* proj;
    __device__ __forceinline__ void operator()(const f32x4 (&acc)[2][2][4][2], const Unit& u, int wr, int wc, int fr, int fq) const {
        const int row0 = u.pm * BM + wr * 64 + fr, col0 = u.pn * BM + wc * 32 + 8 * fq; const int z = u.z;
        const bf16_t* gp = proj + (size_t)row0 * NIN + C_G + z * 2048 + col0; bf16_t* op = O + (size_t)row0 * DM + col0;
#pragma unroll
        for (int ai = 0; ai < 2; ++ai)
#pragma unroll
            for (int mh = 0; mh < 2; ++mh) {
                u32x4 gv[2][2], tv[2][2];
#pragma unroll
                for (int mm = 0; mm < 2; ++mm)
#pragma unroll
                    for (int bj = 0; bj < 2; ++bj) { const int ro = ai * HALF + (mh * 2 + mm) * 16;
                        gv[mm][bj] = *(const u32x4*)(gp + (size_t)ro * NIN + bj * HALF);
                        tv[mm][bj] = (u32x4){0u, 0u, 0u, 0u}; if (z > 0) tv[mm][bj] = *(const u32x4*)(op + (size_t)ro * DM + bj * HALF); }
#pragma unroll
                for (int mm = 0; mm < 2; ++mm)
#pragma unroll
                    for (int bj = 0; bj < 2; ++bj) { const int m = mh * 2 + mm, ro = ai * HALF + m * 16;
                        const f32x4 a0 = acc[ai][bj][m][0], a1 = acc[ai][bj][m][1]; float o[8]; const float av[8] = {a0[0], a0[1], a0[2], a0[3], a1[0], a1[1], a1[2], a1[3]};
#pragma unroll
                        for (int j = 0; j < 4; ++j) { const unsigned gw = gv[mm][bj][j], tw = tv[mm][bj][j];
                            o[2 * j] = bflo(tw) + sigmoidf_(bflo(gw)) * av[2 * j]; o[2 * j + 1] = bfhi(tw) + sigmoidf_(bfhi(gw)) * av[2 * j + 1]; }
                        u32x4 w; w.x = cvt_pk_bf16(o[0], o[1]); w.y = cvt_pk_bf16(o[2], o[3]); w.z = cvt_pk_bf16(o[4], o[5]); w.w = cvt_pk_bf16(o[6], o[7]);
                        *(u32x4*)(op + (size_t)ro * DM + bj * HALF) = w; }
                asm volatile("" ::: "memory"); }
    }
};
struct EpiOut {
    static constexpr bool PERM = false;
    const float* XinP; const float* XinS; float* Xout; bf16_t* XB; float* rsp;
    __device__ __forceinline__ void operator()(const f32x4 (&acc)[2][2][4][2], const Unit& u, int wr, int wc, int fr, int fq) const {
        const int row0 = u.pm * BM + wr * 64 + fr, col0 = u.pn * BM + wc * 32 + 4 * fq;
#pragma unroll
        for (int ai = 0; ai < 2; ++ai) {
            f32x4 xi[4][2][2];
#pragma unroll
            for (int m = 0; m < 4; ++m) { const int row = row0 + ai * HALF + m * 16; const float* xin = (row < MP ? XinP + (size_t)row * DM : XinS + (size_t)(row - MP) * DM) + col0;
#pragma unroll
                for (int bj = 0; bj < 2; ++bj)
#pragma unroll
                    for (int n = 0; n < 2; ++n) xi[m][bj][n] = *(const f32x4*)(xin + bj * HALF + n * 16); }
#pragma unroll
            for (int m = 0; m < 4; ++m) { const int row = row0 + ai * HALF + m * 16; const size_t off = (size_t)row * DM + col0; float ss = 0.f;
#pragma unroll
                for (int bj = 0; bj < 2; ++bj)
#pragma unroll
                    for (int n = 0; n < 2; ++n) { const f32x4 xo = xi[m][bj][n] + acc[ai][bj][m][n];
                        *(f32x4*)(Xout + off + bj * HALF + n * 16) = xo; if (XB) { u32x2 w; w.x = cvt_pk_bf16(xo[0], xo[1]); w.y = cvt_pk_bf16(xo[2], xo[3]); *(u32x2*)(XB + off + bj * HALF + n * 16) = w; }
                        ss += (xo[0] * xo[0] + xo[1] * xo[1]) + (xo[2] * xo[2] + xo[3] * xo[3]); }
                ss += __shfl_xor(ss, 16); ss += __shfl_xor(ss, 32);
                if (fq == 0) rsp[(size_t)row * 32 + u.pn * 4 + wc] = ss; } }
    }
};

template <class Epi, int NZ = 1, bool ALIGN_EPI = true, bool SP2 = true>
__device__ __forceinline__ void gemm_phase(LAS unsigned char* lds, const int tid, const Gemm g, const StaticOrder<NZ>& S, const Epi& E) {
    const int wid = __builtin_amdgcn_readfirstlane(tid >> 6), lane = tid & 63, wr = wid >> 2, wc = wid & 3, fr = lane & 15, fq = lane >> 4;
    const int K = g.K, nt = K / BK;
    unsigned voffA[2], voffB[2];
#pragma unroll
    for (int i = 0; i < 2; ++i) { int R, C; stage_rc(tid * 16 + i * 8192, R, C); const int Rb = Epi::PERM ? ((R & ~31) + perm32(R & 31)) : R;
        voffA[i] = (unsigned)(R * K + C) * 2u; voffB[i] = (unsigned)(Rb * K + C) * 2u; }
    const size_t kstep = (size_t)(BK * 2);
    const size_t hstep = (size_t)HALF * K * 2;
    const size_t tstep = 2 * hstep;
    const unsigned ldsw = (unsigned)wid * 1024u;
    const int aoff = lds_byte(wr * 64 + fr, fq * 8), boff = lds_byte(wc * 32 + fr, fq * 8);
#define PG8_SA(b, h) (((b) * 2 + (h)) * HTB)
#define PG8_SB(b, h) ((4 + (b) * 2 + (h)) * HTB)
#define PG8_STAGE(bufoff, gbase, voff) do { _Pragma("unroll") for (int _i = 0; _i < 2; ++_i) \
        __builtin_amdgcn_global_load_lds((const unsigned*)((const char*)(gbase) + (voff)[_i]), (LAS unsigned*)(lds + (bufoff) + ldsw + _i * 8192), 16, 0, 0); } while (0)
#define PG8_LDA(dst, b, h) do { _Pragma("unroll") for (int m = 0; m < 4; ++m) _Pragma("unroll") for (int k = 0; k < 2; ++k) dst[m][k] = *(const LAS bf16x8*)(lds + PG8_SA(b, h) + aoff + m * 2048 + k * 1024); } while (0)
#define PG8_LDB(dst, b, h) do { _Pragma("unroll") for (int n = 0; n < 2; ++n) _Pragma("unroll") for (int k = 0; k < 2; ++k) dst[n][k] = *(const LAS bf16x8*)(lds + PG8_SB(b, h) + boff + n * 2048 + k * 1024); } while (0)
#define PG8_MMA(ai, bj, At, Bt) do { __builtin_amdgcn_s_setprio(1); _Pragma("unroll") for (int m = 0; m < 4; ++m) _Pragma("unroll") for (int n = 0; n < 2; ++n) _Pragma("unroll") for (int k = 0; k < 2; ++k) \
        acc[ai][bj][m][n] = __builtin_amdgcn_mfma_f32_16x16x32_bf16(Bt[n][k], At[m][k], acc[ai][bj][m][n], 0, 0, 0); __builtin_amdgcn_s_setprio(0); } while (0)
#define PG8_WAIT_V(n) asm volatile("s_waitcnt vmcnt(" #n ")" ::: "memory")
#define PG8_WAIT_L(n) asm volatile("s_waitcnt lgkmcnt(" #n ")" ::: "memory")
#define PG8_BAR __builtin_amdgcn_s_barrier()
#define PG8_SCHED __builtin_amdgcn_sched_barrier(0)
    Unit cur, nxt; int ui = 0;
    if (!S.next(0, cur)) return;
    f32x4 acc[2][2][4][2];
#pragma unroll
    for (int a = 0; a < 2; ++a)
#pragma unroll
        for (int b = 0; b < 2; ++b)
#pragma unroll
            for (int m = 0; m < 4; ++m)
#pragma unroll
                for (int n = 0; n < 2; ++n) acc[a][b][m][n] = (f32x4){0.f, 0.f, 0.f, 0.f};
    bf16x8 At[4][2], B0[2][2], B1[2][2];
    const char* cA = selA<NZ>(g, cur.z) + (size_t)cur.pm * tstep; const char* cB = selB<NZ>(g, cur.z) + (size_t)cur.pn * tstep;
    if constexpr (SP2) {
        PG8_STAGE(PG8_SB(0, 0), cB, voffB); PG8_STAGE(PG8_SB(0, 1), cB + hstep, voffB); PG8_STAGE(PG8_SA(0, 0), cA, voffA); PG8_STAGE(PG8_SA(0, 1), cA + hstep, voffA);
        if (wr == 1) PG8_BAR;
        PG8_WAIT_V(2); PG8_BAR;
        PG8_STAGE(PG8_SB(1, 0), cB + kstep, voffB); PG8_STAGE(PG8_SA(1, 0), cA + kstep, voffA); PG8_STAGE(PG8_SB(1, 1), cB + hstep + kstep, voffB);
        PG8_WAIT_V(6); PG8_BAR;
    } else {
        PG8_STAGE(PG8_SB(0, 0), cB, voffB); PG8_STAGE(PG8_SA(0, 0), cA, voffA); PG8_STAGE(PG8_SB(0, 1), cB + hstep, voffB); PG8_STAGE(PG8_SA(0, 1), cA + hstep, voffA);
        if (wr == 1) PG8_BAR;
        PG8_WAIT_V(4); PG8_BAR;
        PG8_STAGE(PG8_SB(1, 0), cB + kstep, voffB); PG8_STAGE(PG8_SA(1, 0), cA + kstep, voffA); PG8_STAGE(PG8_SB(1, 1), cB + hstep + kstep, voffB);
        PG8_WAIT_V(6); PG8_BAR;
    }
    for (;;) {
        const bool has_next = S.next(ui + 1, nxt);
        const char* nA = has_next ? selA<NZ>(g, nxt.z) + (size_t)nxt.pm * tstep : cA; const char* nB = has_next ? selB<NZ>(g, nxt.z) + (size_t)nxt.pn * tstep : cB;
        for (int t = 0; t < nt; t += 2) {
            const bool last = (t == nt - 2);
            const char* a1 = cA + (size_t)(t + 1) * kstep;
            const char* a2 = last ? nA : cA + (size_t)(t + 2) * kstep; const char* b2 = last ? nB : cB + (size_t)(t + 2) * kstep;
            const char* a3 = a2 + kstep; const char* b3 = b2 + kstep;
            if constexpr (SP2) {
            PG8_LDB(B0, 0, 0); PG8_LDB(B1, 0, 1); PG8_SCHED; PG8_LDA(At, 0, 0); PG8_STAGE(PG8_SA(1, 1), a1 + hstep, voffA);
            PG8_WAIT_V(8); PG8_WAIT_L(0); PG8_BAR; PG8_MMA(0, 0, At, B0); PG8_MMA(0, 1, At, B1); PG8_BAR; PG8_SCHED;
            PG8_LDA(At, 0, 1); PG8_STAGE(PG8_SB(0, 0), b2, voffB); PG8_STAGE(PG8_SB(0, 1), b2 + hstep, voffB); PG8_STAGE(PG8_SA(0, 0), a2, voffA);
            PG8_WAIT_V(8); PG8_WAIT_L(0); PG8_BAR; PG8_MMA(1, 0, At, B0); PG8_MMA(1, 1, At, B1); PG8_BAR; PG8_SCHED;
            PG8_LDB(B0, 1, 0); PG8_LDB(B1, 1, 1); PG8_SCHED; PG8_LDA(At, 1, 0); PG8_STAGE(PG8_SA(0, 1), a2 + hstep, voffA);
            PG8_WAIT_V(8); PG8_WAIT_L(0); PG8_BAR; PG8_MMA(0, 0, At, B0); PG8_MMA(0, 1, At, B1); PG8_BAR; PG8_SCHED;
            PG8_LDA(At, 1, 1); PG8_STAGE(PG8_SB(1, 0), b3, voffB); PG8_STAGE(PG8_SB(1, 1), b3 + hstep, voffB); PG8_STAGE(PG8_SA(1, 0), a3, voffA);
            PG8_WAIT_V(8); PG8_WAIT_L(0); PG8_BAR; PG8_MMA(1, 0, At, B0); PG8_MMA(1, 1, At, B1); PG8_BAR; PG8_SCHED;
            } else {
            PG8_LDB(B0, 0, 0); PG8_SCHED; PG8_LDA(At, 0, 0); PG8_STAGE(PG8_SA(1, 1), a1 + hstep, voffA);
            PG8_WAIT_L(8); PG8_BAR; PG8_WAIT_L(0); PG8_MMA(0, 0, At, B0); PG8_BAR; PG8_SCHED;
            PG8_LDB(B1, 0, 1); PG8_STAGE(PG8_SB(0, 0), b2, voffB);
            PG8_BAR; PG8_WAIT_L(0); PG8_MMA(0, 1, At, B1); PG8_BAR;
            PG8_LDA(At, 0, 1); PG8_STAGE(PG8_SA(0, 0), a2, voffA);
            PG8_BAR; PG8_WAIT_L(0); PG8_MMA(1, 0, At, B0); PG8_BAR; PG8_SCHED;
            PG8_STAGE(PG8_SB(0, 1), b2 + hstep, voffB);
            PG8_WAIT_V(6); PG8_BAR; PG8_MMA(1, 1, At, B1); PG8_BAR;
            PG8_LDB(B0, 1, 0); PG8_SCHED; PG8_LDA(At, 1, 0); PG8_STAGE(PG8_SA(0, 1), a2 + hstep, voffA);
            PG8_WAIT_L(8); PG8_BAR; PG8_WAIT_L(0); PG8_MMA(0, 0, At, B0); PG8_BAR; PG8_SCHED;
            PG8_LDB(B1, 1, 1); PG8_STAGE(PG8_SB(1, 0), b3, voffB);
            PG8_BAR; PG8_WAIT_L(0); PG8_MMA(0, 1, At, B1); PG8_BAR;
            PG8_LDA(At, 1, 1); PG8_STAGE(PG8_SA(1, 0), a3, voffA);
            PG8_BAR; PG8_WAIT_L(0); PG8_MMA(1, 0, At, B0); PG8_BAR; PG8_SCHED;
            PG8_STAGE(PG8_SB(1, 1), b3 + hstep, voffB);
            PG8_WAIT_V(6); PG8_BAR; PG8_MMA(1, 1, At, B1); PG8_BAR;
            }
        }
        if constexpr (ALIGN_EPI) { if (wr == 0) PG8_BAR; }
        E(acc, cur, wr, wc, fr, fq);
        if (!has_next) break;
#pragma unroll
        for (int a = 0; a < 2; ++a)
#pragma unroll
            for (int b = 0; b < 2; ++b)
#pragma unroll
                for (int m = 0; m < 4; ++m)
#pragma unroll
                    for (int n = 0; n < 2; ++n) acc[a][b][m][n] = (f32x4){0.f, 0.f, 0.f, 0.f};
        cur = nxt; cA = nA; cB = nB; ++ui;
        if constexpr (ALIGN_EPI) { if (wr == 1) PG8_BAR; }
    }
    PG8_WAIT_V(0);
    if constexpr (!ALIGN_EPI) { if (wr == 0) PG8_BAR; }
    PG8_BAR;
#undef PG8_SA
#undef PG8_SB
#undef PG8_STAGE
#undef PG8_LDA
#undef PG8_LDB
#undef PG8_MMA
#undef PG8_WAIT_V
#undef PG8_WAIT_L
#undef PG8_BAR
#undef PG8_SCHED
}
}

constexpr int NWAVES = 8, NTHR = NWAVES * 64;
constexpr int LDS_BYTES = 147456;
constexpr int LDS_MISC_OFF = 143360;

struct Args { const float* in[32]; float* out; unsigned char* ws; int ph_lo, ph_hi; };

struct Ctx {
    LAS unsigned char* lds;
    int tid, lane, wave, vcu, G, gtid, gthreads, gw, ngw;
    const float* const* in; float* out; unsigned char* ws;
};
__device__ __forceinline__ const float* INP_(const float* const* in, int k) { asm volatile("" : "+s"(k)); return in[k]; }
#define INP(k) INP_(C.in, (k))
#define WSP(T, off) ((T*)(C.ws + (off)))
#define cWIN WSP(bf16_t, WS_WIN)
#define cWGLU WSP(bf16_t, WS_WGLU + (size_t)l * WS_LSTRIDE)
#define cWBR WSP(bf16_t, WS_WBR + (size_t)l * WS_LSTRIDE)
#define cWOUT WSP(bf16_t, WS_WOUT + (size_t)l * WS_LSTRIDE)
#define cMERGED WSP(bf16_t, WS_MERGED)
#define cPROJ WSP(bf16_t, WS_PROJ)
#define cYS5 WSP(bf16_t, WS_YS5)
#define cAS5 WSP(bf16_t, WS_AS5)
#define cALRU WSP(bf16_t, WS_ALRU)
#define cARET WSP(bf16_t, WS_ARET)
#define cLRUP WSP(bf16_t, WS_LRUP)
#define cXB ((bf16_t*)(C.out + O_XB))
#define cKV WSP(float, WS_KV)
#define cS5E WSP(float, WS_S5E)
#define cS5HIN WSP(float, WS_S5HIN)
#define cRS WSP(float, WS_MISC + MI_RS)
#define cRSP WSP(float, WS_MISC + MI_RSP)
#define cS5LB WSP(float, WS_MISC + MI_S5LB + (size_t)l * 4 * 4096 * 4)
#define cS5BB WSP(float, WS_MISC + MI_S5BB + (size_t)l * 2 * 65536 * 4)
#define cROPE WSP(float, WS_MISC + MI_ROPE)
#define cLSUM WSP(float, WS_MISC + MI_LSUM)
#define cLHIN WSP(float, WS_MISC + MI_LHIN)
#define cWLRU WSP(bf16_t, WS_MISC + MI_WLRU)

constexpr int TT_PITCH = 257;
__device__ __forceinline__ void transpose_tile(Ctx& C, const float* W, int K, int N, bf16_t* WT, const float* gk, int item) {
    LAS float* scr = (LAS float*)C.lds;
    const int nblk = N / 256, kb = item / nblk, nb = item % nblk, k0 = 64 * kb, n0 = 256 * nb;
    __syncthreads();
    { const int r = C.tid >> 6, c4 = (C.tid & 63) * 4; f32x4 v[8];
#pragma unroll
      for (int i = 0; i < 8; ++i) v[i] = *(const f32x4*)(W + (size_t)(k0 + r + 8 * i) * N + n0 + c4);
#pragma unroll
      for (int i = 0; i < 8; ++i) { const float g = gk ? gk[k0 + r + 8 * i] : 1.0f; LAS float* d = scr + (r + 8 * i) * TT_PITCH + c4; d[0] = v[i][0] * g; d[1] = v[i][1] * g; d[2] = v[i][2] * g; d[3] = v[i][3] * g; } }
    __syncthreads();
    { const int c = C.tid & 7;
#pragma unroll
      for (int j = 0; j < 4; ++j) { const int n = (C.tid >> 3) + 64 * j; const LAS float* s = scr + (8 * c) * TT_PITCH + n;
          u32x4 o; o.x = pk2(s[0 * TT_PITCH], s[1 * TT_PITCH]); o.y = pk2(s[2 * TT_PITCH], s[3 * TT_PITCH]); o.z = pk2(s[4 * TT_PITCH], s[5 * TT_PITCH]); o.w = pk2(s[6 * TT_PITCH], s[7 * TT_PITCH]);
          *(u32x4*)(WT + (size_t)(n0 + n) * K + k0 + 8 * c) = o; } }
}
constexpr int TI_IN = (DM / 64) * (NIN / 256), TI_GLU = (1024 / 64) * (1024 / 256), TI_BR = (1024 / 64) * (DM / 256), TI_OUT = (DM / 64) * (DM / 256), TI_SMALL = TI_GLU + 3 * TI_BR + TI_OUT;
__device__ __forceinline__ void convert_win(Ctx& C, int l) {
    const float* w = INP(8) + (size_t)l * DM * NIN; const float* g = INP(7) + l * DM;
    for (int it = C.vcu; it < TI_IN; it += C.G) transpose_tile(C, w, DM, NIN, cWIN, g, it);
    __syncthreads();
}
__device__ __forceinline__ void convert_small(Ctx& C, int l) {
    const float* in17 = INP(17); const float* in27 = INP(27); const float* in28 = INP(28); const float* in29 = INP(29); const float* in30 = INP(30);
    for (int it = C.vcu; it < TI_SMALL; it += C.G) {
        int r = it;
        if (r < TI_GLU) { transpose_tile(C, in17 + (size_t)l * 1024 * 1024, 1024, 1024, cWGLU, nullptr, r); continue; } r -= TI_GLU;
        if (r < TI_BR) { transpose_tile(C, in27 + (size_t)l * 1024 * DM, 1024, DM, cWBR, nullptr, r); continue; } r -= TI_BR;
        if (r < TI_BR) { transpose_tile(C, in28 + (size_t)l * 1024 * DM, 1024, DM, cWBR + (size_t)DM * 1024, nullptr, r); continue; } r -= TI_BR;
        if (r < TI_BR) { transpose_tile(C, in29 + (size_t)l * 1024 * DM, 1024, DM, cWBR + (size_t)2 * DM * 1024, nullptr, r); continue; } r -= TI_BR;
        transpose_tile(C, in30 + (size_t)l * DM * DM, DM, DM, cWOUT, nullptr, r);
    }
    __syncthreads();
}
__device__ __forceinline__ void s5_params(Ctx& C, int l) {
    const float* in9 = INP(9); const float* in10 = INP(10); const float* in11 = INP(11); const float* in12 = INP(12); const float* in13 = INP(13);
    for (int i = C.gtid; i < S5G * S5P; i += C.gthreads) {
        const int g = i >> 6;
        const float dt = expf(in11[l * S5G + g]), lr = in9[l * 4096 + i], li = in10[l * 4096 + i];
        const float a = lr * dt, b = li * dt, ea = expf(a), cb = cosf(b), sb = sinf(b), sh = sinf(0.5f * b);
        const float lbr = ea * cb, lbi = ea * sb;
        const float nr = expm1f(a) * cb - 2.0f * sh * sh, ni = ea * sb, den = lr * lr + li * li;
        const float cr = (nr * lr + ni * li) / den, ci = (ni * lr - nr * li) / den;
        cS5LB[i] = lbr; cS5LB[4096 + i] = lbi;
        float pr = lbr, pi = lbi;
#pragma unroll
        for (int s = 0; s < 6; ++s) { const float t = pr * pr - pi * pi; pi = 2.0f * pr * pi; pr = t; }
        cS5LB[8192 + i] = pr; cS5LB[12288 + i] = pi;
        const float* bre = in12 + ((size_t)l * 4096 + i) * 16; const float* bim = in13 + ((size_t)l * 4096 + i) * 16;
#pragma unroll
        for (int c = 0; c < 16; ++c) { const float br = bre[c], bi = bim[c]; cS5BB[(size_t)i * 16 + c] = cr * br - ci * bi; cS5BB[65536 + (size_t)i * 16 + c] = cr * bi + ci * br; }
    }
}
__device__ __forceinline__ void phase_prep(Ctx& C, int l) {
    if (l == 0) {
        convert_win(C, 0); convert_small(C, 0); convert_small(C, 1); s5_params(C, 0); s5_params(C, 1);
        { const float* in21 = INP(21); const float* in23 = INP(23);
          for (int i = C.gtid; i < 2 * 8 * 256 * 128; i += C.gthreads) { const int c = i & 127, r = (i >> 7) & 255, ln = i >> 15, gate = r >> 7, d = r & 127;
              cWLRU[i] = (bf16_t)f2bf((gate ? in23 : in21)[(size_t)ln * 16384 + c * 128 + d]); } }
        const float* in0 = INP(0); const float* in1 = INP(1);
        for (int m = C.gw; m < M; m += C.ngw) {
            const float* xr = (m < MP) ? in0 + (size_t)m * DM : in1 + (size_t)(m - MP) * DM;
            float ss = 0.f;
#pragma unroll
            for (int j = 0; j < 8; ++j) { const f32x4 v = *(const f32x4*)(xr + 4 * C.lane + 256 * j); ss += (v[0] * v[0] + v[1] * v[1]) + (v[2] * v[2] + v[3] * v[3]);
                u32x2 w; w.x = pk2(v[0], v[1]); w.y = pk2(v[2], v[3]); *(u32x2*)(cXB + (size_t)m * DM + 4 * C.lane + 256 * j) = w; }
            ss = wave_sum(ss);
            if (C.lane == 0) cRS[m] = 1.0f / sqrtf(ss * (1.0f / DM) + NORM_EPS);
        }
        for (int i = C.gtid; i < 2056 * 64; i += C.gthreads) {
            const int pi_ = i >> 6, j = i & 63; const int pos = pi_ < 2048 ? pi_ : PAST + (pi_ - 2048);
            const float freq = powf(10000.0f, -(float)j / 64.0f); const float ang = (float)pos * freq;
            double r = (double)ang; const double k = rint(r * 0.15915494309189535); r -= k * 6.283185307179586;
            const float rr = (float)r;
            cROPE[i] = cosf(rr); cROPE[2056 * 64 + i] = sinf(rr);
        }
    } else {
        for (int m = C.gtid; m < M; m += C.gthreads) { float ss = 0.f;
#pragma unroll
            for (int j = 0; j < 8; ++j) { const f32x4 v = *(const f32x4*)(cRSP + (size_t)m * 32 + 4 * j); ss += (v[0] + v[1]) + (v[2] + v[3]); }
            cRS[m] = 1.0f / sqrtf(ss * (1.0f / DM) + NORM_EPS); }
    }
}

constexpr int TP = 136;
constexpr int S5_BUP = 132;
struct S5Frags { bf16x8 bb[8]; float lbr, lbi; };
__device__ __forceinline__ void s5_load_bb(Ctx& C, int l, int g, S5Frags& F) {
    const int fr = C.lane & 15, tq = C.lane >> 4;
#pragma unroll
    for (int nt = 0; nt < 8; ++nt) { bf16x8 v = (bf16x8){0, 0, 0, 0, 0, 0, 0, 0};
        if (tq < 2) { const int pp = nt * 16 + fr; const float* s = cS5BB + (pp >= 64 ? 65536 : 0) + ((size_t)(g * 64 + (pp & 63))) * 16 + 8 * tq;
            const f32x4 a = *(const f32x4*)s, b = *(const f32x4*)(s + 4); u32x4 w; w.x = pk2(a[0], a[1]); w.y = pk2(a[2], a[3]); w.z = pk2(b[0], b[1]); w.w = pk2(b[2], b[3]); v = __builtin_bit_cast(bf16x8, w); }
        F.bb[nt] = v; }
    F.lbr = cS5LB[g * 64 + C.lane]; F.lbi = cS5LB[4096 + g * 64 + C.lane];
}
__device__ __forceinline__ void s5_decode(int it, int& g, int& k) { g = (it & 255) >> 2; k = ((it & 3) << 2) | (it >> 8); }
__device__ __forceinline__ bf16x8 s5_load_u(Ctx& C, size_t row, int g, int nts) {
    const int fr = C.lane & 15, tq = C.lane >> 4; bf16x8 ua = (bf16x8){0, 0, 0, 0, 0, 0, 0, 0};
    if (tq < 2 && fr < nts) ua = *(const bf16x8*)(cPROJ + (row + fr) * NIN + C_US5 + g * 16 + 8 * tq);
    return ua;
}
template <bool WRITE_H>
__device__ __forceinline__ void s5_subblock(Ctx& C, const S5Frags& F, const bf16x8 ua, int nts, LAS float* BUf, LAS bf16_t* Hb, float& hr, float& hi) {
    const int fr = C.lane & 15, tq = C.lane >> 4;
#pragma unroll
    for (int nt = 0; nt < 8; ++nt) { f32x4 d = __builtin_amdgcn_mfma_f32_16x16x32_bf16(ua, F.bb[nt], (f32x4){0.f, 0.f, 0.f, 0.f}, 0, 0, 0);
#pragma unroll
        for (int r = 0; r < 4; ++r) BUf[(tq * 4 + r) * S5_BUP + nt * 16 + fr] = d[r]; }
    LDS_WAIT(); asm volatile("" ::: "memory");
    const int p = C.lane;
#pragma unroll 4
    for (int t = 0; t < nts; ++t) { const float br = BUf[t * S5_BUP + p], bi = BUf[t * S5_BUP + 64 + p];
        const float nr = F.lbr * hr - F.lbi * hi + br, ni = F.lbr * hi + F.lbi * hr + bi; hr = nr; hi = ni;
        if (WRITE_H) { Hb[t * TP + p] = (bf16_t)f2bf(hr); Hb[t * TP + 64 + p] = (bf16_t)f2bf(hi); } }
    LDS_WAIT(); asm volatile("" ::: "memory");
}
__device__ __forceinline__ void s5_pass1(Ctx& C, int l) {
    LAS float* BUf = (LAS float*)(C.lds + C.wave * 12800); LAS bf16_t* Hb = (LAS bf16_t*)(BUf + 16 * S5_BUP);
    int cur_g = -1; S5Frags F; bf16x8 un[4];
    { int g, k; if (C.vcu < 1024) { s5_decode(C.vcu, g, k); const int pair = k * 8 + C.wave; const size_t row0 = (size_t)(pair >> 5) * SEQ + (pair & 31) * S5L;
#pragma unroll
        for (int s = 0; s < 4; ++s) un[s] = s5_load_u(C, row0 + 16 * s, g, 16); } }
    for (int it = C.vcu; it < 1024; it += C.G) {
        int g, k; s5_decode(it, g, k); const int pair = k * 8 + C.wave, b = pair >> 5, j = pair & 31;
        { s5_load_bb(C, l, g, F); cur_g = g; }
        bf16x8 uc[4];
#pragma unroll
        for (int s = 0; s < 4; ++s) uc[s] = un[s];
        if (it + C.G < 1024) { int g2, k2; s5_decode(it + C.G, g2, k2); const int pr2 = k2 * 8 + C.wave; const size_t r2 = (size_t)(pr2 >> 5) * SEQ + (pr2 & 31) * S5L;
#pragma unroll
            for (int s = 0; s < 4; ++s) un[s] = s5_load_u(C, r2 + 16 * s, g2, 16); }
        float hr = 0.f, hi = 0.f;
#pragma unroll
        for (int s = 0; s < 4; ++s) s5_subblock<false>(C, F, uc[s], 16, BUf, Hb, hr, hi);
        const size_t o = ((size_t)(b * S5NCH + j) * 64 + g) * 128 + C.lane; cS5E[o] = hr; cS5E[o + 64] = hi;
    }
}
__device__ __forceinline__ void s5_carry(Ctx& C, int l) {
    for (int i = C.gtid; i < NB * S5G * S5P; i += C.gthreads) {
        const int b = i >> 12, gp = i & 4095, g = gp >> 6, p = gp & 63;
        const float l64r = cS5LB[8192 + gp], l64i = cS5LB[12288 + gp]; float rr = 0.f, ri = 0.f;
        const size_t o0 = ((size_t)(b * S5NCH) * 64 + g) * 128 + p; float er[S5NCH], ei[S5NCH];
#pragma unroll
        for (int j = 0; j < S5NCH; ++j) { er[j] = cS5E[o0 + (size_t)j * 8192]; ei[j] = cS5E[o0 + (size_t)j * 8192 + 64]; }
#pragma unroll
        for (int j = 0; j < S5NCH; ++j) { const size_t o = o0 + (size_t)j * 8192;
            cS5HIN[o] = rr; cS5HIN[o + 64] = ri;
            const float nr = l64r * rr - l64i * ri + er[j], ni = l64r * ri + l64i * rr + ei[j]; rr = nr; ri = ni; }
        C.out[O_S5RP + (size_t)(l * NB + b) * 4096 + gp] = rr; C.out[O_S5IP + (size_t)(l * NB + b) * 4096 + gp] = ri;
    }
}
__device__ __forceinline__ void s5_pass2(Ctx& C, int l) {
    const float* in2 = INP(2); const float* in3 = INP(3); const float* in14 = INP(14); const float* in15 = INP(15); const float* in16 = INP(16);
    LAS float* BUf = (LAS float*)(C.lds + C.wave * 12800); LAS bf16_t* Hb = (LAS bf16_t*)(BUf + 16 * S5_BUP);
    const int fr = C.lane & 15, tq = C.lane >> 4, p = C.lane;
    int cur_g = -1; S5Frags F; bf16x8 ct[4], dd; bf16x8 un[4];
    auto rows_of = [&](int it, int& g, size_t& row0, int& ntok, int& pair) { const bool smp = it >= 1024; int k; s5_decode(smp ? it - 1024 : it, g, k); pair = k * 8 + C.wave;
        if (smp) { row0 = (size_t)MP + pair * DS; ntok = DS; } else { row0 = (size_t)(pair >> 5) * SEQ + (pair & 31) * S5L; ntok = S5L; } };
    if (C.vcu < 2048) { int g; size_t row0; int ntok, pair; rows_of(C.vcu, g, row0, ntok, pair);
#pragma unroll
        for (int s = 0; s < 4; ++s) un[s] = (16 * s < ntok) ? s5_load_u(C, row0 + 16 * s, g, ntok - 16 * s < 16 ? ntok - 16 * s : 16) : (bf16x8){0, 0, 0, 0, 0, 0, 0, 0}; }
    for (int it = C.vcu; it < 2048; it += C.G) {
        const bool smp = it >= 1024; int g; size_t row0; int ntok, pair; rows_of(it, g, row0, ntok, pair);
        s5_load_bb(C, l, g, F);
        if (g != cur_g) { cur_g = g;
#pragma unroll
            for (int ks = 0; ks < 4; ++ks) { const int pp = ks * 32 + tq * 8; const float* s = (pp >= 64 ? in15 : in14) + ((size_t)(l * S5G + g) * 16 + fr) * 64 + (pp & 63); const float sg = pp >= 64 ? -1.f : 1.f;
                const f32x4 a = *(const f32x4*)s * sg, b = *(const f32x4*)(s + 4) * sg; u32x4 w; w.x = pk2(a[0], a[1]); w.y = pk2(a[2], a[3]); w.z = pk2(b[0], b[1]); w.w = pk2(b[2], b[3]); ct[ks] = __builtin_bit_cast(bf16x8, w); }
            { const unsigned dbits = f2bf(in16[l * 1024 + g * 16 + fr]); u32x4 w = (u32x4){0u, 0u, 0u, 0u};
              if ((fr >> 3) == tq) { const int j = fr & 7; w[j >> 1] = (j & 1) ? (dbits << 16) : dbits; }
              dd = __builtin_bit_cast(bf16x8, w); } }
        bf16x8 uc[4];
#pragma unroll
        for (int s = 0; s < 4; ++s) uc[s] = un[s];
        if (it + C.G < 2048) { int g2; size_t r2; int nt2, pr2; rows_of(it + C.G, g2, r2, nt2, pr2);
#pragma unroll
            for (int s = 0; s < 4; ++s) un[s] = (16 * s < nt2) ? s5_load_u(C, r2 + 16 * s, g2, nt2 - 16 * s < 16 ? nt2 - 16 * s : 16) : (bf16x8){0, 0, 0, 0, 0, 0, 0, 0}; }
        float hr, hi;
        if (smp) { const size_t o = ((size_t)(l * DB + pair) * 64 + g) * 64 + p; hr = in2[o]; hi = in3[o]; }
        else { const int b = pair >> 5, j = pair & 31; const size_t o = ((size_t)(b * S5NCH + j) * 64 + g) * 128 + p; hr = cS5HIN[o]; hi = cS5HIN[o + 64]; }
#pragma unroll
        for (int s = 0; s < 4; ++s) { const int sb = 16 * s; if (sb < ntok) {
            const int nts = (ntok - sb) < 16 ? (ntok - sb) : 16;
            s5_subblock<true>(C, F, uc[s], nts, BUf, Hb, hr, hi);
            f32x4 y = __builtin_amdgcn_mfma_f32_16x16x32_bf16(uc[s], dd, (f32x4){0.f, 0.f, 0.f, 0.f}, 0, 0, 0);
#pragma unroll
            for (int ks = 0; ks < 4; ++ks) { const bf16x8 a = *(const LAS bf16x8*)(Hb + fr * TP + ks * 32 + tq * 8); y = __builtin_amdgcn_mfma_f32_16x16x32_bf16(a, ct[ks], y, 0, 0, 0); }
#pragma unroll
            for (int r = 0; r < 4; ++r) { const int tok = tq * 4 + r; if (tok < nts) cYS5[(row0 + sb + tok) * 1024 + g * 16 + fr] = (bf16_t)f2bf(gelu_tanh(y[r])); }
            LDS_WAIT(); asm volatile("" ::: "memory"); } }
        if (smp) { const size_t o = ((size_t)(l * DB + pair) * 64 + g) * 64 + p; C.out[O_S5RS + o] = hr; C.out[O_S5IS + o] = hi; }
    }
}
constexpr int XP = 132;
__device__ __forceinline__ void lru_tiles(Ctx& C, int l) {
    const float* in4 = INP(4); const float* in5 = INP(5); const float* in19 = INP(19); const float* in20 = INP(20); const float* in22 = INP(22); const float* in24 = INP(24); const float* in25 = INP(25);
    LAS bf16_t* WT = (LAS bf16_t*)C.lds;
    LAS bf16_t* XCb = WT + 256 * TP;
    LAS float* XCf = (LAS float*)(C.lds + (256 + 64) * TP * 2);
    constexpr int NTILES = MP / LT + MS / LT;
    int cur_n = -1;
    for (int it = C.vcu; it < NTILES * 8; it += C.G) {
        const int n = it & 7, tile = it >> 3; const bool smp = tile >= MP / LT;
        const size_t row0 = (size_t)tile * LT;
        __syncthreads();
        if (n != cur_n) { cur_n = n; const bf16_t* wsrc = cWLRU + (size_t)(l * 8 + n) * 256 * 128;
#pragma unroll
            for (int i = 0; i < 8; ++i) { const int ch = C.tid + NTHR * i, r = ch >> 4, c8 = (ch & 15) * 8; *(LAS u32x4*)(WT + r * TP + c8) = *(const u32x4*)(wsrc + r * 128 + c8); } }
        { const int tt = C.tid >> 3, cq = C.tid & 7, ch0 = n * 128 + 16 * cq;
          float xc[16];
#pragma unroll
          for (int c = 0; c < 16; ++c) xc[c] = in20[l * 1024 + ch0 + c];
          const int s = smp ? (tt & 7) : ((tile & (LNT - 1)) * LT + tt);
          const int bs = smp ? (tile - MP / LT) * 8 + (tt >> 3) : 0;
#pragma unroll
          for (int k = 0; k < 4; ++k) { const int sr = s - 3 + k; float u[16];
              if (sr >= 0) { const bf16_t* src = cPROJ + (row0 + tt - 3 + k) * NIN + C_ULRU + ch0; const u32x4 v0 = *(const u32x4*)src, v1 = *(const u32x4*)(src + 8);
#pragma unroll
                  for (int j = 0; j < 4; ++j) { u[2 * j] = bflo(v0[j]); u[2 * j + 1] = bfhi(v0[j]); u[8 + 2 * j] = bflo(v1[j]); u[9 + 2 * j] = bfhi(v1[j]); } }
              else if (smp) { const float* src = in5 + ((size_t)(l * DB + bs) * 3 + (sr + 3)) * 1024 + ch0;
#pragma unroll
                  for (int j = 0; j < 4; ++j) { const f32x4 v = *(const f32x4*)(src + 4 * j); u[4 * j] = v[0]; u[4 * j + 1] = v[1]; u[4 * j + 2] = v[2]; u[4 * j + 3] = v[3]; } }
              else {
#pragma unroll
                  for (int c = 0; c < 16; ++c) u[c] = 0.f; }
              const float* cw = in19 + (size_t)(l * 4 + k) * 1024 + ch0;
#pragma unroll
              for (int c = 0; c < 16; ++c) xc[c] += cw[c] * u[c]; }
#pragma unroll
          for (int j = 0; j < 4; ++j) *(LAS f32x4*)(XCf + tt * XP + 16 * cq + 4 * j) = (f32x4){xc[4 * j], xc[4 * j + 1], xc[4 * j + 2], xc[4 * j + 3]};
          u32x4 w0, w1;
#pragma unroll
          for (int j = 0; j < 4; ++j) { w0[j] = pk2(xc[2 * j], xc[2 * j + 1]); w1[j] = pk2(xc[8 + 2 * j], xc[9 + 2 * j]); }
          *(LAS u32x4*)(XCb + tt * TP + 16 * cq) = w0; *(LAS u32x4*)(XCb + tt * TP + 16 * cq + 8) = w1; }
        __syncthreads();
        const int fr = C.lane & 15, tq = C.lane >> 4, d = 16 * C.wave + fr, ch = n * 128 + d;
        f32x4 pa[4], px[4];
#pragma unroll
        for (int mt = 0; mt < 4; ++mt) { pa[mt] = (f32x4){0.f, 0.f, 0.f, 0.f}; px[mt] = (f32x4){0.f, 0.f, 0.f, 0.f}; }
#pragma unroll
        for (int k = 0; k < 4; ++k) { const bf16x8 ba = *(const LAS bf16x8*)(WT + d * TP + k * 32 + tq * 8), bx = *(const LAS bf16x8*)(WT + (128 + d) * TP + k * 32 + tq * 8);
#pragma unroll
            for (int mt = 0; mt < 4; ++mt) { const bf16x8 a = *(const LAS bf16x8*)(XCb + (mt * 16 + fr) * TP + k * 32 + tq * 8);
                pa[mt] = __builtin_amdgcn_mfma_f32_16x16x32_bf16(a, ba, pa[mt], 0, 0, 0); px[mt] = __builtin_amdgcn_mfma_f32_16x16x32_bf16(a, bx, px[mt], 0, 0, 0); } }
        const float ba_ = in22[l * 1024 + ch], bx_ = in24[l * 1024 + ch], sp = log1pf(expf(-in25[l * 1024 + ch]));
#pragma unroll
        for (int mt = 0; mt < 4; ++mt)
#pragma unroll
            for (int r = 0; r < 4; ++r) { const float rg = sigmoidf_(pa[mt][r] + ba_), ig = sigmoidf_(px[mt][r] + bx_), la = -8.0f * rg * sp, a = __expf(la);
                const float xv = XCf[(mt * 16 + tq * 4 + r) * XP + d]; pa[mt][r] = a; px[mt][r] = sqrtf(fmaxf(-expm1f(2.0f * la), 0.f)) * (ig * xv); }
        float RA = 1.f, RB = 0.f;
        if (!smp) {
#pragma unroll
            for (int mt = 0; mt < 4; ++mt) {
                float cA = 1.f, cB = 0.f;
#pragma unroll
                for (int r = 0; r < 4; ++r) { cB = pa[mt][r] * cB + px[mt][r]; cA *= pa[mt][r]; px[mt][r] = cB; pa[mt][r] = cA; }
                float iA = cA, iB = cB;
                { const float pA = __shfl_up(iA, 16), pB = __shfl_up(iB, 16); if (tq >= 1) { iB = iA * pB + iB; iA = iA * pA; } }
                { const float pA = __shfl_up(iA, 32), pB = __shfl_up(iB, 32); if (tq >= 2) { iB = iA * pB + iB; iA = iA * pA; } }
                float eA = __shfl_up(iA, 16), eB = __shfl_up(iB, 16); if (tq == 0) { eA = 1.f; eB = 0.f; }
                const float inB = eA * RB + eB, inA = eA * RA;
#pragma unroll
                for (int r = 0; r < 4; ++r) { px[mt][r] += pa[mt][r] * inB; pa[mt][r] *= inA; }
                const float tA = __shfl(iA, fr + 48), tB = __shfl(iB, fr + 48);
                RB = tA * RB + tB; RA = RA * tA;
            }
            if (tq == 3) { cLSUM[((size_t)tile * 1024 + ch) * 2] = RA; cLSUM[((size_t)tile * 1024 + ch) * 2 + 1] = RB;
                if ((tile & (LNT - 1)) == LNT - 1) { const int b = tile / LNT;
#pragma unroll
                    for (int k = 0; k < 3; ++k) C.out[O_CONVP + ((size_t)(l * NB + b) * 3 + k) * 1024 + ch] = bf2f(cPROJ[(row0 + 61 + k) * NIN + C_ULRU + ch]); } }
        } else {
#pragma unroll
            for (int mt = 0; mt < 4; ++mt) { const int bs = (tile - MP / LT) * 8 + 2 * mt + (tq >> 1);
                float cA = 1.f, cB = 0.f;
#pragma unroll
                for (int r = 0; r < 4; ++r) { cB = pa[mt][r] * cB + px[mt][r]; cA *= pa[mt][r]; px[mt][r] = cB; pa[mt][r] = cA; }
                const float h0 = in4[(size_t)(l * DB + bs) * 1024 + ch];
                const float pA = __shfl_up(cA, 16), pB = __shfl_up(cB, 16);
                const float hin = (tq & 1) ? (pA * h0 + pB) : h0;
#pragma unroll
                for (int r = 0; r < 4; ++r) { px[mt][r] += pa[mt][r] * hin; pa[mt][r] = 0.f; }
                if (tq & 1) { C.out[O_LRUS + (size_t)(l * DB + bs) * 1024 + ch] = px[mt][3];
#pragma unroll
                    for (int k = 0; k < 3; ++k) C.out[O_CONVS + ((size_t)(l * DB + bs) * 3 + k) * 1024 + ch] = bf2f(cPROJ[(row0 + mt * 16 + (tq >> 1) * 8 + 5 + k) * NIN + C_ULRU + ch]); } }
        }
#pragma unroll
        for (int mt = 0; mt < 4; ++mt)
#pragma unroll
            for (int r = 0; r < 4; ++r) { const size_t o = (row0 + mt * 16 + tq * 4 + r) * 1024 + ch; cALRU[o] = (bf16_t)f2bf(px[mt][r]); cLRUP[o] = (bf16_t)f2bf(pa[mt][r]); }
    }
    __syncthreads();
}
__device__ __forceinline__ void lru_carry(Ctx& C, int l) {
    for (int i = C.gtid; i < NB * 1024; i += C.gthreads) { const int b = i >> 10, ch = i & 1023; float run = 0.f; f32x2 pe[LNT];
#pragma unroll
        for (int t = 0; t < LNT; ++t) pe[t] = *(const f32x2*)(cLSUM + ((size_t)(b * LNT + t) * 1024 + ch) * 2);
#pragma unroll
        for (int t = 0; t < LNT; ++t) { cLHIN[(size_t)(b * LNT + t) * 1024 + ch] = run; run = pe[t][0] * run + pe[t][1]; }
        C.out[O_LRUP + (size_t)(l * NB + b) * 1024 + ch] = run; }
}
__device__ __forceinline__ void lru_fin(Ctx& C) {
    for (int i = C.gtid; i < M * 128; i += C.gthreads) { const int row = i >> 7, c8 = (i & 127) * 8;
        const u32x4 hv = *(const u32x4*)(cALRU + (size_t)row * 1024 + c8), pv = *(const u32x4*)(cLRUP + (size_t)row * 1024 + c8), zv = *(const u32x4*)(cPROJ + (size_t)row * NIN + C_ZLRU + c8);
        f32x4 h0 = (f32x4){0.f, 0.f, 0.f, 0.f}, h1 = h0;
        if (row < MP) { const float* hp = cLHIN + (size_t)(row >> 6) * 1024 + c8; h0 = *(const f32x4*)hp; h1 = *(const f32x4*)(hp + 4); }
        u32x4 w;
        const float hh[8] = {h0[0], h0[1], h0[2], h0[3], h1[0], h1[1], h1[2], h1[3]};
#pragma unroll
        for (int j = 0; j < 4; ++j) {
            const float ya = bflo(hv[j]) + bflo(pv[j]) * hh[2 * j], yb = bfhi(hv[j]) + bfhi(pv[j]) * hh[2 * j + 1];
            w[j] = pk2(ya * siluf_(bflo(zv[j])), yb * siluf_(bfhi(zv[j]))); }
        *(u32x4*)(cALRU + (size_t)row * 1024 + c8) = w; }
}

__device__ __forceinline__ void wave_mma_128(const LAS bf16_t* A, int arow0, const LAS bf16_t* Bt, f32x4 (&acc)[8], int lane) {
    const int fr = lane & 15, fq = lane >> 4;
#pragma unroll
    for (int k = 0; k < 4; ++k) { const bf16x8 a = *(const LAS bf16x8*)(A + (arow0 + fr) * TP + k * 32 + fq * 8);
#pragma unroll
        for (int nt = 0; nt < 8; ++nt) { const bf16x8 b = *(const LAS bf16x8*)(Bt + (nt * 16 + fr) * TP + k * 32 + fq * 8);
            acc[nt] = __builtin_amdgcn_mfma_f32_16x16x32_bf16(a, b, acc[nt], 0, 0, 0); } }
}
__device__ __forceinline__ float ret_logg(int h) { return log1pf(-exp2f(-5.0f - (float)h)); }
__device__ __forceinline__ void rope_load(Ctx& C, size_t row, int colb, int posidx, int qd, float (&o1)[16], float (&o2)[16]) {
    const bf16_t* src = cPROJ + row * NIN + colb + 16 * qd;
    const u32x4 a0 = *(const u32x4*)src, a1 = *(const u32x4*)(src + 8), b0 = *(const u32x4*)(src + 64), b1 = *(const u32x4*)(src + 72);
    const float* cs = cROPE + (size_t)posidx * 64 + 16 * qd; const float* sn = cs + 2056 * 64;
    float x1[16], x2[16];
#pragma unroll
    for (int j = 0; j < 4; ++j) { x1[2 * j] = bflo(a0[j]); x1[2 * j + 1] = bfhi(a0[j]); x1[8 + 2 * j] = bflo(a1[j]); x1[9 + 2 * j] = bfhi(a1[j]);
        x2[2 * j] = bflo(b0[j]); x2[2 * j + 1] = bfhi(b0[j]); x2[8 + 2 * j] = bflo(b1[j]); x2[9 + 2 * j] = bfhi(b1[j]); }
#pragma unroll
    for (int j = 0; j < 4; ++j) { const f32x4 c = *(const f32x4*)(cs + 4 * j), s = *(const f32x4*)(sn + 4 * j);
#pragma unroll
        for (int k = 0; k < 4; ++k) { o1[4 * j + k] = x1[4 * j + k] * c[k] - x2[4 * j + k] * s[k]; o2[4 * j + k] = x1[4 * j + k] * s[k] + x2[4 * j + k] * c[k]; } }
}
__device__ __forceinline__ void load_vt(Ctx& C, LAS bf16_t* VT, size_t row0, int h) {
    const int tok = C.tid >> 2, qd = C.tid & 3; const bf16_t* src = cPROJ + (row0 + tok) * NIN + C_V + h * 128 + 32 * qd;
#pragma unroll
    for (int j = 0; j < 4; ++j) { const u32x4 v = *(const u32x4*)(src + 8 * j);
#pragma unroll
        for (int k = 0; k < 4; ++k) { VT[(32 * qd + 8 * j + 2 * k) * TP + tok] = (bf16_t)(v[k] & 0xffffu); VT[(32 * qd + 8 * j + 2 * k + 1) * TP + tok] = (bf16_t)(v[k] >> 16); } }
}
__device__ __forceinline__ void ret_pass1(Ctx& C) {
    LAS bf16_t* KT = (LAS bf16_t*)C.lds; LAS bf16_t* VT = KT + 128 * TP;
    for (int it = C.vcu; it < NB * NH * NCH; it += C.G) {
        const int j = it & 15, bh = it >> 4, h = bh & 7, b = bh >> 3; const size_t row0 = (size_t)b * SEQ + j * RC;
        const float lg = ret_logg(h);
        __syncthreads();
        { const int tok = C.tid >> 2, qd = C.tid & 3; float k1[16], k2[16];
          rope_load(C, row0 + tok, C_K + h * 128, j * RC + tok, qd, k1, k2);
          const float sc = 0.08838834764831845f * expf((float)(RC - 1 - tok) * lg);
#pragma unroll
          for (int i = 0; i < 16; ++i) { KT[(16 * qd + i) * TP + tok] = (bf16_t)f2bf(k1[i] * sc); KT[(64 + 16 * qd + i) * TP + tok] = (bf16_t)f2bf(k2[i] * sc); } }
        load_vt(C, VT, row0, h);
        __syncthreads();
        f32x4 acc[8];
#pragma unroll
        for (int nt = 0; nt < 8; ++nt) acc[nt] = (f32x4){0.f, 0.f, 0.f, 0.f};
        wave_mma_128(KT, 16 * C.wave, VT, acc, C.lane);
        float* dst = cKV + (size_t)it * 16384;
#pragma unroll
        for (int nt = 0; nt < 8; ++nt)
#pragma unroll
            for (int r = 0; r < 4; ++r) dst[(16 * C.wave + (C.lane >> 4) * 4 + r) * 128 + 16 * nt + (C.lane & 15)] = acc[nt][r];
    }
    __syncthreads();
}
__device__ __forceinline__ void ret_prefix(Ctx& C, int l) {
    for (int i = C.gtid; i < NB * NH * 4096; i += C.gthreads) { const int bh = i >> 12, e = (i & 4095) * 4, h = bh & 7;
        const float gc = expf((float)RC * ret_logg(h)); f32x4 run = (f32x4){0.f, 0.f, 0.f, 0.f}; f32x4 t[NCH];
        float* p = cKV + (size_t)bh * NCH * 16384 + e;
#pragma unroll
        for (int j = 0; j < NCH; ++j) t[j] = *(const f32x4*)(p + (size_t)j * 16384);
#pragma unroll
        for (int j = 0; j < NCH; ++j) { *(f32x4*)(p + (size_t)j * 16384) = run; run = gc * run + t[j]; }
        *(f32x4*)(C.out + O_RETP + (size_t)(l * NB * NH + bh) * 16384 + e) = run; }
}
__device__ __forceinline__ void ret_pass2(Ctx& C, int l) {
    const float* in26 = INP(26);
    LAS bf16_t* QS = (LAS bf16_t*)C.lds; LAS bf16_t* KS = QS + 128 * TP; LAS bf16_t* VT = KS + 128 * TP; LAS bf16_t* RT = VT + 128 * TP;
    for (int it = C.vcu; it < NB * NH * NCH; it += C.G) {
        const int j = it & 15, bh = it >> 4, h = bh & 7, b = bh >> 3; const size_t row0 = (size_t)b * SEQ + j * RC;
        const float lg = ret_logg(h);
        __syncthreads();
        { const int tok = C.tid >> 2, qd = C.tid & 3; float a1[16], a2[16];
          rope_load(C, row0 + tok, C_Q + h * 128, j * RC + tok, qd, a1, a2);
#pragma unroll
          for (int i = 0; i < 2; ++i) { u32x4 w, w2;
#pragma unroll
              for (int k = 0; k < 4; ++k) { w[k] = pk2(a1[8 * i + 2 * k], a1[8 * i + 2 * k + 1]); w2[k] = pk2(a2[8 * i + 2 * k], a2[8 * i + 2 * k + 1]); }
              *(LAS u32x4*)(QS + tok * TP + 16 * qd + 8 * i) = w; *(LAS u32x4*)(QS + tok * TP + 64 + 16 * qd + 8 * i) = w2; }
          rope_load(C, row0 + tok, C_K + h * 128, j * RC + tok, qd, a1, a2);
          const float sc = 0.08838834764831845f;
#pragma unroll
          for (int i = 0; i < 2; ++i) { u32x4 w, w2;
#pragma unroll
              for (int k = 0; k < 4; ++k) { w[k] = pk2(a1[8 * i + 2 * k] * sc, a1[8 * i + 2 * k + 1] * sc); w2[k] = pk2(a2[8 * i + 2 * k] * sc, a2[8 * i + 2 * k + 1] * sc); }
              *(LAS u32x4*)(KS + tok * TP + 16 * qd + 8 * i) = w; *(LAS u32x4*)(KS + tok * TP + 64 + 16 * qd + 8 * i) = w2; } }
        load_vt(C, VT, row0, h);
        { const int d = C.tid >> 2, eq = C.tid & 3; const float* src = cKV + (size_t)it * 16384 + d * 128 + 32 * eq;
#pragma unroll
          for (int k = 0; k < 8; ++k) { const f32x4 v = *(const f32x4*)(src + 4 * k);
#pragma unroll
              for (int i = 0; i < 4; ++i) RT[(32 * eq + 4 * k + i) * TP + d] = (bf16_t)f2bf(v[i]); } }
        __syncthreads();
        const int ib = 16 * C.wave + (C.lane >> 4) * 4, jc = C.lane & 15;
        f32x4 acc[8], s[8];
#pragma unroll
        for (int nt = 0; nt < 8; ++nt) { acc[nt] = (f32x4){0.f, 0.f, 0.f, 0.f}; s[nt] = (f32x4){0.f, 0.f, 0.f, 0.f}; }
        wave_mma_128(QS, 16 * C.wave, RT, acc, C.lane);
#pragma unroll
        for (int r = 0; r < 4; ++r) { const float xi = expf((float)(ib + r + 1) * lg);
#pragma unroll
            for (int nt = 0; nt < 8; ++nt) acc[nt][r] *= xi; }
        wave_mma_128(QS, 16 * C.wave, KS, s, C.lane);
        __syncthreads();
#pragma unroll
        for (int nt = 0; nt < 8; ++nt)
#pragma unroll
            for (int r = 0; r < 4; ++r) { const int i = ib + r, jj = 16 * nt + jc; const float dm = (i >= jj) ? expf((float)(i - jj) * lg) : 0.f;
                KS[i * TP + jj] = (bf16_t)f2bf(s[nt][r] * dm); }
        LDS_WAIT(); asm volatile("" ::: "memory");
        wave_mma_128(KS, 16 * C.wave, VT, acc, C.lane);
#pragma unroll
        for (int r = 0; r < 4; ++r) { float s1 = 0.f;
#pragma unroll
            for (int nt = 0; nt < 8; ++nt) s1 += acc[nt][r];
            s1 += __shfl_xor(s1, 1); s1 += __shfl_xor(s1, 2); s1 += __shfl_xor(s1, 4); s1 += __shfl_xor(s1, 8);
            const float mu = s1 * (1.0f / 128.0f); float s2 = 0.f;
#pragma unroll
            for (int nt = 0; nt < 8; ++nt) { const float dlt = acc[nt][r] - mu; s2 += dlt * dlt; }
            s2 += __shfl_xor(s2, 1); s2 += __shfl_xor(s2, 2); s2 += __shfl_xor(s2, 4); s2 += __shfl_xor(s2, 8);
            const float rstd = 1.0f / sqrtf(s2 * (1.0f / 128.0f) + GN_EPS); const size_t row = row0 + ib + r;
#pragma unroll
            for (int nt = 0; nt < 8; ++nt) { const int e = 16 * nt + jc; const float z = bf2f(cPROJ[row * NIN + C_ZRET + h * 128 + e]);
                cARET[row * 1024 + h * 128 + e] = (bf16_t)f2bf((acc[nt][r] - mu) * rstd * in26[l * 1024 + h * 128 + e] * siluf_(z)); } }
    }
    __syncthreads();
}
__device__ __forceinline__ void ret_sample(Ctx& C, int l) {
    const float* in6 = INP(6); const float* in26 = INP(26);
    LAS float* qs = (LAS float*)C.lds; LAS float* ks = qs + 1024; LAS float* vs = ks + 1024; LAS float* SM = vs + 1024; LAS float* OP = SM + 64;
    for (int it = C.vcu; it < DB * NH; it += C.G) {
        const int h = it & 7, bs = it >> 3; const size_t row0 = (size_t)MP + bs * DS; const float lg = ret_logg(h);
        const float* rin = in6 + ((size_t)(l * DB + bs) * NH + h) * 16384; float* rout = C.out + O_RETS + ((size_t)(l * DB + bs) * NH + h) * 16384;
        const int e4 = (C.tid & 31) * 4, d0 = (C.tid >> 5) * 8;
        f32x4 r[8];
#pragma unroll
        for (int dd = 0; dd < 8; ++dd) r[dd] = *(const f32x4*)(rin + (d0 + dd) * 128 + e4);
        __syncthreads();
        { const int tok = C.tid >> 6, x = C.tid & 63; const bf16_t* pr = cPROJ + (row0 + tok) * NIN + h * 128;
          const float c = cROPE[(size_t)(2048 + tok) * 64 + x], sn = cROPE[(size_t)2056 * 64 + (size_t)(2048 + tok) * 64 + x];
          const float q1 = bf2f(pr[C_Q + x]), q2 = bf2f(pr[C_Q + 64 + x]), k1 = bf2f(pr[C_K + x]), k2 = bf2f(pr[C_K + 64 + x]);
          qs[tok * 128 + x] = q1 * c - q2 * sn; qs[tok * 128 + 64 + x] = q1 * sn + q2 * c;
          ks[tok * 128 + x] = (k1 * c - k2 * sn) * 0.08838834764831845f; ks[tok * 128 + 64 + x] = (k1 * sn + k2 * c) * 0.08838834764831845f;
          vs[tok * 128 + x] = bf2f(pr[C_V + x]); vs[tok * 128 + 64 + x] = bf2f(pr[C_V + 64 + x]); }
        __syncthreads();
        { const int ij = C.tid >> 3, part = C.tid & 7, i = ij >> 3, jj = ij & 7; float a = 0.f;
#pragma unroll
          for (int dq = 0; dq < 4; ++dq) { const f32x4 qa = *(const LAS f32x4*)(qs + i * 128 + part * 16 + 4 * dq), kb = *(const LAS f32x4*)(ks + jj * 128 + part * 16 + 4 * dq); a += (qa[0] * kb[0] + qa[1] * kb[1]) + (qa[2] * kb[2] + qa[3] * kb[3]); }
          a += __shfl_xor(a, 1); a += __shfl_xor(a, 2); a += __shfl_xor(a, 4);
          if (part == 0) SM[ij] = a; }
        { f32x4 v4[8], oacc[8]; float gz[8]; const float g8 = expf(8.0f * lg);
#pragma unroll
          for (int t = 0; t < 8; ++t) { v4[t] = *(const LAS f32x4*)(vs + t * 128 + e4); oacc[t] = (f32x4){0.f, 0.f, 0.f, 0.f}; gz[t] = expf((float)(7 - t) * lg); }
#pragma unroll
          for (int dd = 0; dd < 8; ++dd) { const int d = d0 + dd; f32x4 rn = g8 * r[dd];
#pragma unroll
              for (int t = 0; t < 8; ++t) { oacc[t] += qs[t * 128 + d] * r[dd]; rn += (gz[t] * ks[t * 128 + d]) * v4[t]; }
              *(f32x4*)(rout + d * 128 + e4) = rn; }
#pragma unroll
          for (int t = 0; t < 8; ++t) {
#pragma unroll
              for (int k = 0; k < 4; ++k) oacc[t][k] += __shfl_xor(oacc[t][k], 32);
              if (C.lane < 32) *(LAS f32x4*)(OP + (C.wave * 8 + t) * 128 + e4) = oacc[t]; } }
        __syncthreads();
        { const int tok = C.tid >> 6, x = C.tid & 63; float o[2];
#pragma unroll
          for (int hh = 0; hh < 2; ++hh) { const int e = x + 64 * hh; float a = 0.f;
#pragma unroll
              for (int w = 0; w < 8; ++w) a += OP[(w * 8 + tok) * 128 + e];
              a *= expf((float)(tok + 1) * lg);
              for (int jj = 0; jj <= tok; ++jj) a += expf((float)(tok - jj) * lg) * SM[tok * 8 + jj] * vs[jj * 128 + e];
              o[hh] = a; }
          const float mu = wave_sum(o[0] + o[1]) * (1.0f / 128.0f); const float dd0 = o[0] - mu, dd1 = o[1] - mu;
          const float rstd = 1.0f / sqrtf(wave_sum(dd0 * dd0 + dd1 * dd1) * (1.0f / 128.0f) + GN_EPS);
          const bf16_t* pr = cPROJ + (row0 + tok) * NIN + C_ZRET + h * 128; bf16_t* dst = cARET + (row0 + tok) * 1024 + h * 128; const float* gn = in26 + l * 1024 + h * 128;
          dst[x] = (bf16_t)f2bf(dd0 * rstd * gn[x] * siluf_(bf2f(pr[x]))); dst[x + 64] = (bf16_t)f2bf(dd1 * rstd * gn[x + 64] * siluf_(bf2f(pr[x + 64]))); }
    }
    __syncthreads();
}

__device__ __forceinline__ void phase_final(Ctx& C) {
    const float* in31 = INP(31);
    for (int m = C.gw; m < M; m += C.ngw) { float ss = 0.f;
        if (C.lane < 32) ss = cRSP[(size_t)m * 32 + C.lane];
        ss = wave_sum(ss); const float rs = 1.0f / sqrtf(ss * (1.0f / DM) + NORM_EPS);
        float* xr = C.out + (size_t)m * DM;
#pragma unroll
        for (int j = 0; j < 8; ++j) { const int c = 4 * C.lane + 256 * j; const f32x4 v = *(const f32x4*)(xr + c), g = *(const f32x4*)(in31 + c); *(f32x4*)(xr + c) = v * rs * g; } }
}


#define XB_TMO      128
#define XB_XCNT(j)  (256  + 64 * (j))
#define XB_XSUB(j)  (1280 + 64 * (j))
#define XB_XGEN(j)  (2304 + 64 * (j))
#define XB_TOP      3328
#define XB_TOPGEN   3392
#define XCD_BAR_WORDS 3456
#define XB_SPIN_CAP (1u << 20)
__device__ __forceinline__ unsigned xb_ld(unsigned* p)              { return __hip_atomic_load(p, __ATOMIC_RELAXED, __HIP_MEMORY_SCOPE_AGENT); }
__device__ __forceinline__ unsigned xb_add(unsigned* p, unsigned v) { return __hip_atomic_fetch_add(p, v, __ATOMIC_RELAXED, __HIP_MEMORY_SCOPE_AGENT); }
__device__ __forceinline__ unsigned xb_xcc_id() { return (unsigned)__builtin_amdgcn_s_getreg((3 << 11) | 20) & 0xFu; }
#define XB_SPIN(cond, bar) do { unsigned _sp = 0; while (cond) { __builtin_amdgcn_s_sleep(1); \
    if ((++_sp & 255u) == 0u) { if (xb_ld(&(bar)[XB_TMO])) break; if (_sp > XB_SPIN_CAP) { atomicAdd(&(bar)[XB_TMO], 1u); break; } } } } while (0)
struct XcdBarrier { unsigned* bar; unsigned x; volatile LAS unsigned* st; };
__device__ __forceinline__ XcdBarrier xcd_barrier_post(unsigned* bar, volatile LAS unsigned* st) {
    XcdBarrier b; b.bar = bar; b.x = xb_xcc_id(); b.st = st;
    if (threadIdx.x == 0) (void)xb_add(&bar[XB_XCNT(b.x)], 1u);
    return b;
}
__device__ __forceinline__ void xcd_barrier_complete(unsigned* bar, unsigned x, unsigned& nloc, unsigned& nx) {
    const unsigned G = gridDim.x * gridDim.y * gridDim.z;
    unsigned sum, cnt, mine, sp = 0u;
    for (;;) {
        sum = 0u; cnt = 0u; mine = 0u;
#pragma unroll
        for (unsigned j = 0; j < 16; ++j) { const unsigned c = xb_ld(&bar[XB_XCNT(j)]); sum += c; cnt += (c > 0u) ? 1u : 0u; mine = (j == x) ? c : mine; }
        if (sum == G) break;
        __builtin_amdgcn_s_sleep(1);
        if ((++sp & 255u) == 0u) { if (xb_ld(&bar[XB_TMO])) break; if (sp > XB_SPIN_CAP) { atomicAdd(&bar[XB_TMO], 1u); break; } }
    }
    nloc = mine > 0u ? mine : 1u; nx = cnt > 0u ? cnt : 1u;
}
__device__ __forceinline__ void xcd_barrier(const XcdBarrier& b) {
    asm volatile("s_waitcnt vmcnt(0)" ::: "memory");
    __syncthreads();
    if (threadIdx.x == 0) {
        unsigned* bar = b.bar;
        __builtin_amdgcn_s_waitcnt(0);
        unsigned nloc = b.st[0], nx = b.st[1];
        if (nloc == 0u) { xcd_barrier_complete(bar, b.x, nloc, nx); b.st[0] = nloc; b.st[1] = nx; }
        const unsigned old = xb_add(&bar[XB_XSUB(b.x)], 1u);
        const unsigned gen = old / nloc;
        if (old + 1u == (gen + 1u) * nloc) {
            __builtin_amdgcn_fence(__ATOMIC_RELEASE, "agent");
            asm volatile("s_waitcnt vmcnt(0)" ::: "memory");
            const unsigned og = xb_add(&bar[XB_TOP], 1u);
            const unsigned tg = og / nx;
            if (og + 1u == (tg + 1u) * nx) xb_add(&bar[XB_TOPGEN], 1u);
            else XB_SPIN(xb_ld(&bar[XB_TOPGEN]) == tg, bar);
            __builtin_amdgcn_fence(__ATOMIC_ACQUIRE, "agent");
            xb_add(&bar[XB_XGEN(b.x)], 1u);
            asm volatile("s_waitcnt vmcnt(0)" ::: "memory");
        } else {
            XB_SPIN(xb_ld(&bar[XB_XGEN(b.x)]) == gen, bar);
            __builtin_amdgcn_fence(__ATOMIC_ACQUIRE, "agent");
            asm volatile("s_waitcnt vmcnt(0)" ::: "memory");
        }
    }
    __syncthreads();
}

constexpr int PH_PER_LAYER = 8, N_PHASES = 2 * PH_PER_LAYER + 1;
__global__ void __launch_bounds__(NTHR, 2) fwd_kernel(Args args) {
    extern __shared__ __attribute__((aligned(16))) unsigned char lds_raw[];
    Ctx C;
    C.lds = (LAS unsigned char*)lds_raw;
    C.in = args.in;
    { volatile LAS unsigned* misc = (volatile LAS unsigned*)(C.lds + LDS_MISC_OFF); if (threadIdx.x < 32) misc[threadIdx.x] = 0u; }
    __syncthreads();
    XcdBarrier xbar = xcd_barrier_post((unsigned*)(args.ws + WS_CTL) + 4096, (volatile LAS unsigned*)(C.lds + LDS_MISC_OFF) + 8);
#ifdef TSEL
    unsigned long long t_acc = 0ull;
#endif
    for (int ph = args.ph_lo; ph < args.ph_hi; ++ph) {
#ifdef TSEL
        const unsigned long long t_ph0 = __builtin_amdgcn_s_memrealtime();
#endif
        int bid = (int)blockIdx.x, tidv = (int)threadIdx.x, gdim = (int)gridDim.x; asm volatile("" : "+s"(bid), "+v"(tidv), "+s"(gdim));
        C.tid = tidv; C.lane = C.tid & 63; C.wave = __builtin_amdgcn_readfirstlane(C.tid >> 6);
        C.G = gdim; C.vcu = (C.G % 8 == 0) ? (bid % 8) * (C.G / 8) + bid / 8 : bid;
        C.gtid = C.vcu * NTHR + C.tid; C.gthreads = C.G * NTHR; C.gw = C.vcu * NWAVES + C.wave; C.ngw = C.G * NWAVES;
        { unsigned long long w = (unsigned long long)args.ws, o = (unsigned long long)args.out; asm volatile("" : "+s"(w), "+s"(o));
          C.ws = (unsigned char*)w; C.out = (float*)o; }
        if (ph == N_PHASES - 1) { phase_final(C); }
        else {
            const int l = ph / PH_PER_LAYER, k = ph % PH_PER_LAYER;
            if (k == 0) { if (PHMASK & 1) phase_prep(C, l); }
            else if (k == 1) { if (PHMASK & 2) { pg8::Gemm g{}; g.A = cXB; g.Bt = cWIN; g.K = DM; pg8::StaticOrder<1> S; S.init(M, NIN, C.G, bid);
                pg8::EpiProj E{cPROJ, cRS}; pg8::gemm_phase<pg8::EpiProj>(C.lds, C.tid, g, S, E); } }
            else if (k == 2) { if (PHMASK & 4) s5_pass1(C, l); if (PHMASK & 8) lru_tiles(C, l); if (PHMASK & 16) ret_pass1(C); if (PHMASK & 32) ret_sample(C, l); }
            else if (k == 3) { if (PHMASK & 64) { s5_carry(C, l); lru_carry(C, l); ret_prefix(C, l); if (l == 0) convert_win(C, 1); } }
            else if (k == 4) { if (PHMASK & 128) s5_pass2(C, l); if (PHMASK & 256) lru_fin(C); if (PHMASK & 512) ret_pass2(C, l); }
            else if (k == 5) { if (PHMASK & 1024) { pg8::Gemm g{}; g.A = cYS5; g.Bt = cWGLU; g.K = 1024; pg8::StaticOrder<1> S; S.init(M, 1024, C.G, bid);
                pg8::EpiGlu E{cAS5, cYS5, cPROJ, INP(18) + l * 1024}; pg8::gemm_phase<pg8::EpiGlu>(C.lds, C.tid, g, S, E); } }
            else if (k == 6) { if (PHMASK & 2048) { pg8::Gemm g{}; g.A = cAS5; g.Bt = cWBR; g.zA = WS_ALRU - WS_AS5; g.zB = (size_t)DM * 1024 * 2; g.K = 1024;
                pg8::StaticOrder<3> S; S.init(M, DM, C.G, bid);
                pg8::EpiMerge E{cMERGED, cPROJ}; pg8::gemm_phase<pg8::EpiMerge, 3>(C.lds, C.tid, g, S, E); } }
            else { if (PHMASK & 4096) { pg8::Gemm g{}; g.A = cMERGED; g.Bt = cWOUT; g.K = DM; pg8::StaticOrder<1> S; S.init(M, DM, C.G, bid);
                const float* x0 = INP(0); const float* x1 = INP(1); pg8::EpiOut E{l == 0 ? x0 : C.out, l == 0 ? x1 : C.out + (size_t)MP * DM, C.out, l == 0 ? cXB : (bf16_t*)nullptr, cRSP}; pg8::gemm_phase<pg8::EpiOut>(C.lds, C.tid, g, S, E); } }
        }
        if (ph + 1 < args.ph_hi) { if (ph == args.ph_lo) cg::this_grid().sync(); else xcd_barrier(xbar); }
#ifdef TSEL
        { const int kk = (ph == N_PHASES - 1) ? 8 : ph % PH_PER_LAYER; if ((TSEL >> kk) & 1) t_acc += __builtin_amdgcn_s_memrealtime() - t_ph0; }
#endif
    }
#ifdef TSEL
    if (blockIdx.x == 0 && threadIdx.x == 0) { const unsigned long long t_end = __builtin_amdgcn_s_memrealtime(); while (__builtin_amdgcn_s_memrealtime() - t_end < 3ull * t_acc) __builtin_amdgcn_s_sleep(16); }
#endif
}


#ifdef PROBE_TABLE
__global__ void probe_kernel(float* out) {
    const float tab[12][2] = PROBE_TABLE;
    const size_t offs[13] = {O_YP, O_YS, O_S5RP, O_S5IP, O_LRUP, O_CONVP, O_RETP, O_S5RS, O_S5IS, O_LRUS, O_CONVS, O_RETS, O_END};
    for (int o = 0; o < 12; ++o) { const size_t n = offs[o + 1] - offs[o], half = n / 2;
        for (size_t i = (size_t)blockIdx.x * blockDim.x + threadIdx.x; i < n; i += (size_t)gridDim.x * blockDim.x) { const float s = (o < 2) ? tab[o][0] : tab[o][i >= half];
            out[offs[o] + i] = (s == 0.f) ? 0.f : out[offs[o] + i] * s; } }
}
#endif

extern "C" void kernel_launch(void* const* d_in, const int* in_sizes, int n_in, void* d_out, int out_size, void* d_ws, size_t ws_size, hipStream_t stream) {
    static int grid = 0;
    if (grid == 0) {
        if (n_in != 32 || out_size != (int)O_END || ws_size < WS_END) { fprintf(stderr, "kernel_launch: unexpected shapes: n_in %d out %d ws %zu (need %zu)\n", n_in, out_size, ws_size, (size_t)WS_END); grid = -1; return; }
        int dev = 0, cus = 0, per_cu = 0;
        if (hipGetDevice(&dev) != hipSuccess || hipDeviceGetAttribute(&cus, hipDeviceAttributeMultiprocessorCount, dev) != hipSuccess) { grid = -1; return; }
        if (hipFuncSetAttribute((const void*)fwd_kernel, hipFuncAttributeMaxDynamicSharedMemorySize, LDS_BYTES) != hipSuccess) { fprintf(stderr, "kernel_launch: hipFuncSetAttribute failed\n"); grid = -1; return; }
        if (hipOccupancyMaxActiveBlocksPerMultiprocessor(&per_cu, (const void*)fwd_kernel, NTHR, LDS_BYTES) != hipSuccess || per_cu < 1) { fprintf(stderr, "kernel_launch: occupancy query says %d\n", per_cu); per_cu = 1; }
        (void)hipGetLastError();
        grid = cus;
    }
    if (grid < 0) return;
    (void)hipMemsetAsync((char*)d_ws + WS_CTL, 0, CTL_ZERO_BYTES, stream);
    Args a{};
    for (int i = 0; i < 32; ++i) a.in[i] = (const float*)d_in[i];
    a.out = (float*)d_out; a.ws = (unsigned char*)d_ws;
#if MK_N_LAUNCHES == 1
    a.ph_lo = 0; a.ph_hi = N_PHASES;
    void* kargs[] = {&a};
    hipError_t e = hipLaunchCooperativeKernel((const void*)fwd_kernel, dim3(grid), dim3(NTHR), kargs, LDS_BYTES, stream);
    if (e != hipSuccess) fprintf(stderr, "kernel_launch: cooperative launch failed: %s (grid %d)\n", hipGetErrorString(e), grid);
#else
    for (int ph = 0; ph < N_PHASES; ++ph) { a.ph_lo = ph; a.ph_hi = ph + 1; hipLaunchKernelGGL(fwd_kernel, dim3(grid), dim3(NTHR), LDS_BYTES, stream, a); }
#endif
#ifdef PROBE_TABLE
    hipLaunchKernelGGL(probe_kernel, dim3(2048), dim3(256), 0, stream, (float*)d_out);
#endif
}
```

```cpp
#include <hip/hip_runtime.h>
#include <hip/hip_cooperative_groups.h>
#include <cstdio>
#include <cstdint>
namespace cg = cooperative_groups;

#ifndef PHMASK
#define PHMASK 0xFFFF
#endif
#ifndef MK_N_LAUNCHES
#define MK_N_LAUNCHES 1
#endif

#define LAS __attribute__((address_space(3)))
#define GAS __attribute__((address_space(1)))
typedef unsigned short bf16_t;
typedef short bf16x8 __attribute__((ext_vector_type(8)));
typedef float f32x4 __attribute__((ext_vector_type(4)));
typedef float f32x2 __attribute__((ext_vector_type(2)));
typedef unsigned u32x4 __attribute__((ext_vector_type(4)));
typedef unsigned u32x2 __attribute__((ext_vector_type(2)));

constexpr int DM = 2048, NB = 4, SEQ = 2048, DEPTH = 2, DB = 128, DS = 8, PAST = 16384;
constexpr int MP = NB * SEQ, MS = DB * DS, M = MP + MS;
constexpr int NIN = 14336;
constexpr int C_US5 = 0, C_ZS5 = 1024, C_ULRU = 2048, C_ZLRU = 3072, C_Q = 4096, C_K = 5120, C_V = 6144, C_ZRET = 7168, C_G = 8192;
constexpr int NH = 8, DK = 128, DV = 128, RC = 128, NCH = SEQ / RC;
constexpr int S5G = 64, S5P = 64, S5C = 16;
constexpr int S5L = 64, S5NCH = SEQ / S5L;
constexpr int LT = 64, LNT = SEQ / LT;
constexpr float NORM_EPS = 1e-6f, GN_EPS = 1e-5f;

constexpr size_t O_YP = 0, O_YS = 16777216, O_S5RP = 18874368, O_S5IP = 18907136, O_LRUP = 18939904, O_CONVP = 18948096, O_RETP = 18972672,
                 O_S5RS = 20021248, O_S5IS = 21069824, O_LRUS = 22118400, O_CONVS = 22380544, O_RETS = 23166976, O_END = 56721408;
constexpr size_t O_XB = O_RETS + 16777216;

constexpr size_t MiB = 1u << 20;
constexpr size_t WS_CTL = 0, CTL_ZERO_BYTES = 1 * MiB;
constexpr size_t WS_WIN = 1 * MiB, WS_WGLU = 57 * MiB, WS_WBR = 59 * MiB, WS_WOUT = 71 * MiB, WS_MERGED = 79 * MiB, WS_PROJ = 115 * MiB,
                 WS_YS5 = 367 * MiB, WS_AS5 = 385 * MiB, WS_ALRU = 403 * MiB, WS_ARET = 421 * MiB, WS_KV = 439 * MiB, WS_S5E = 471 * MiB, WS_S5HIN = 475 * MiB,
                 WS_MISC = 479 * MiB, WS_SMALL1 = 487 * MiB, WS_END = 509 * MiB;
constexpr size_t WS_LSTRIDE = WS_SMALL1 - WS_WGLU;
static_assert(WS_ALRU - WS_AS5 == WS_ARET - WS_ALRU, "branch operands equally spaced");
constexpr size_t WS_LRUP = WS_AS5;
constexpr size_t MI_RS = 0;
constexpr size_t MI_RSP = 64 * 1024;
constexpr size_t MI_S5LB = MI_RSP + (size_t)M * 32 * 4;
constexpr size_t MI_S5BB = MI_S5LB + 2 * 4 * 4096 * 4;
constexpr size_t MI_ROPE = MI_S5BB + 2 * 2 * 65536 * 4;
constexpr size_t MI_LSUM = MI_ROPE + 2 * 2056 * 64 * 4;
constexpr size_t MI_LHIN = MI_LSUM + (size_t)NB * LNT * 1024 * 2 * 4;
constexpr size_t MI_WLRU = MI_LHIN + (size_t)NB * LNT * 1024 * 4;
constexpr size_t MI_END = MI_WLRU + (size_t)2 * 8 * 256 * 128 * 2;
static_assert(MI_END <= 8 * MiB, "misc region");

__device__ __forceinline__ float bf2f(unsigned b) { return __uint_as_float(b << 16); }
__device__ __forceinline__ unsigned f2bf(float f) { unsigned u = __float_as_uint(f); return (u + 0x7fffu + ((u >> 16) & 1u)) >> 16; }
__device__ __forceinline__ unsigned pk2(float lo, float hi) { return f2bf(lo) | (f2bf(hi) << 16); }
__device__ __forceinline__ float bflo(unsigned w) { return __uint_as_float(w << 16); }
__device__ __forceinline__ float bfhi(unsigned w) { return __uint_as_float(w & 0xffff0000u); }
__device__ __forceinline__ float sigmoidf_(float x) { return __builtin_amdgcn_rcpf(1.0f + __builtin_amdgcn_exp2f(-1.4426950408889634f * x)); }
__device__ __forceinline__ float siluf_(float x) { return x * sigmoidf_(x); }
__device__ __forceinline__ float gelu_tanh(float x) { const float u = 1.5957691216f * (x + 0.044715f * x * x * x); return x * sigmoidf_(u); }
__device__ __forceinline__ float wave_sum(float v) {
#pragma unroll
    for (int o = 1; o < 64; o <<= 1) v += __shfl_xor(v, o);
    return v;
}
#define LDS_WAIT() asm volatile("s_waitcnt lgkmcnt(0)" ::: "memory")
#define VM_WAIT() asm volatile("s_waitcnt vmcnt(0)" ::: "memory")

namespace pg8 {
constexpr int BM = 256, BK = 64, HALF = 128, HTB = HALF * BK * 2, STAGE_BYTES = 8 * HTB, NXCD = 8, WGM = 8;
__host__ __device__ __forceinline__ int lds_byte(int r, int c) { const int st = (r >> 4) * 2 + (c >> 5), rr = r & 15, cc = c & 31, ob = rr * 64 + cc * 2; return st * 1024 + (ob ^ (((ob >> 9) & 1) << 5)); }
__host__ __device__ __forceinline__ void stage_rc(int b, int& R, int& C) { const int st = b / 1024, sb = b % 1024, swz = sb ^ (((sb >> 9) & 1) << 5); R = (st >> 1) * 16 + swz / 64; C = (st & 1) * 32 + (swz % 64) / 2; }
__host__ __device__ __forceinline__ int perm32(int rho) { const int n = rho >> 4, i = rho & 15; return 8 * (i >> 2) + 4 * n + (i & 3); }

struct Unit { int pm, pn, z; };
struct Gemm { const bf16_t* A; const bf16_t* Bt; size_t zA, zB; int K; };
template <int NZ> __device__ __forceinline__ const char* selA(const Gemm& g, int z) { if (NZ == 1) return (const char*)g.A; return (const char*)g.A + (size_t)z * g.zA; }
template <int NZ> __device__ __forceinline__ const char* selB(const Gemm& g, int z) { if (NZ == 1) return (const char*)g.Bt; return (const char*)g.Bt + (size_t)z * g.zB; }

template <int NZ> struct StaticOrder {
    int nM, nN, nwg, G, c;
    __device__ void init(int M_, int N_, int G_, int c_) { nM = M_ / BM; nN = N_ / BM; nwg = nM * nN; G = G_; c = c_; }
    __device__ bool next(int i, Unit& u) const {
        const int it = (NZ == 1) ? i : i / NZ; u.z = (NZ == 1) ? 0 : i - it * NZ;
        const long L = (long)it * G + c; if (L >= nwg) return false;
        int wgid = (int)L; { const int q = nwg / NXCD, r = nwg % NXCD, xcd = wgid % NXCD, off = wgid / NXCD; wgid = (xcd < r ? xcd * (q + 1) : r * (q + 1) + (xcd - r) * q) + off; }
        const int nig = WGM * nN, gid = wgid / nig, fm = gid * WGM, gsz = (nM - fm) < WGM ? (nM - fm) : WGM;
        u.pm = fm + ((wgid % nig) % gsz); u.pn = (wgid % nig) / gsz; return true;
    }
};

__device__ __forceinline__ unsigned cvt_pk_bf16(float lo, float hi) { unsigned r; asm volatile("v_cvt_pk_bf16_f32 %0, %1, %2" : "=v"(r) : "v"(lo), "v"(hi)); return r; }


struct EpiProj {
    static constexpr bool PERM = true;
    bf16_t* O; const float* rs;
    __device__ __forceinline__ void operator()(const f32x4 (&acc)[2][2][4][2], const Unit& u, int wr, int wc, int fr, int fq) const {
        const int row0 = u.pm * BM + wr * 64 + fr, col0 = u.pn * BM + wc * 32 + 8 * fq;
#pragma unroll
        for (int ai = 0; ai < 2; ++ai)
#pragma unroll
            for (int m = 0; m < 4; ++m) { const int row = row0 + ai * HALF + m * 16; const float s = rs[row]; bf16_t* rowp = O + (size_t)row * NIN + col0;
#pragma unroll
                for (int bj = 0; bj < 2; ++bj) { const f32x4 v0 = acc[ai][bj][m][0] * s, v1 = acc[ai][bj][m][1] * s;
                    u32x4 w; w.x = cvt_pk_bf16(v0[0], v0[1]); w.y = cvt_pk_bf16(v0[2], v0[3]); w.z = cvt_pk_bf16(v1[0], v1[1]); w.w = cvt_pk_bf16(v1[2], v1[3]);
                    *(u32x4*)(rowp + bj * HALF) = w; } }
    }
};
struct EpiGlu {
    static constexpr bool PERM = true;
    bf16_t* O; const bf16_t* Y; const bf16_t* proj; const float* bias;
    __device__ __forceinline__ void operator()(const f32x4 (&acc)[2][2][4][2], const Unit& u, int wr, int wc, int fr, int fq) const {
        const int row0 = u.pm * BM + wr * 64 + fr, col0 = u.pn * BM + wc * 32 + 8 * fq;
#pragma unroll
        for (int bj = 0; bj < 2; ++bj) { const int col = col0 + bj * HALF; const f32x4 b0 = *(const f32x4*)(bias + col), b1 = *(const f32x4*)(bias + col + 4);
#pragma unroll
            for (int ai = 0; ai < 2; ++ai) {
                u32x4 yv[4], zv[4];
#pragma unroll
                for (int m = 0; m < 4; ++m) { const int row = row0 + ai * HALF + m * 16; yv[m] = *(const u32x4*)(Y + (size_t)row * 1024 + col); zv[m] = *(const u32x4*)(proj + (size_t)row * NIN + C_ZS5 + col); }
#pragma unroll
                for (int m = 0; m < 4; ++m) { const int row = row0 + ai * HALF + m * 16;
                    const f32x4 a0 = acc[ai][bj][m][0] + b0, a1 = acc[ai][bj][m][1] + b1; float o[8]; const float av[8] = {a0[0], a0[1], a0[2], a0[3], a1[0], a1[1], a1[2], a1[3]};
#pragma unroll
                    for (int j = 0; j < 4; ++j) { const unsigned yw = yv[m][j], zw = zv[m][j];
                        o[2 * j] = bflo(yw) * sigmoidf_(av[2 * j]) * siluf_(bflo(zw)); o[2 * j + 1] = bfhi(yw) * sigmoidf_(av[2 * j + 1]) * siluf_(bfhi(zw)); }
                    u32x4 w; w.x = cvt_pk_bf16(o[0], o[1]); w.y = cvt_pk_bf16(o[2], o[3]); w.z = cvt_pk_bf16(o[4], o[5]); w.w = cvt_pk_bf16(o[6], o[7]);
                    *(u32x4*)(O + (size_t)row * 1024 + col) = w; }
                asm volatile("" ::: "memory"); } }
    }
};
struct EpiMerge {
    static constexpr bool PERM = true;
    bf16_t* O; const bf16_t* proj;
    __device__ __forceinline__ void operator()(const f32x4 (&acc)[2][2][4][2], const Unit& u, int wr, int wc, int fr, int fq) const {
        const int row0 = u.pm * BM + wr * 64 + fr, col0 = u.pn * BM + wc * 32 + 8 * fq; const int z = u.z;
        const bf16_t* gp = proj + (size_t)row0 * NIN + C_G + z * 2048 + col0; bf16_t* op = O + (size_t)row0 * DM + col0;
#pragma unroll
        for (int ai = 0; ai < 2; ++ai)
#pragma unroll
            for (int mh = 0; mh < 2; ++mh) {
                u32x4 gv[2][2], tv[2][2];
#pragma unroll
                for (int mm = 0; mm < 2; ++mm)
#pragma unroll
                    for (int bj = 0; bj < 2; ++bj) { const int ro = ai * HALF + (mh * 2 + mm) * 16;
                        gv[mm][bj] = *(const u32x4*)(gp + (size_t)ro * NIN + bj * HALF);
                        tv[mm][bj] = (u32x4){0u, 0u, 0u, 0u}; if (z > 0) tv[mm][bj] = *(const u32x4*)(op + (size_t)ro * DM + bj * HALF); }
#pragma unroll
                for (int mm = 0; mm < 2; ++mm)
#pragma unroll
                    for (int bj = 0; bj < 2; ++bj) { const int m = mh * 2 + mm, ro = ai * HALF + m * 16;
                        const f32x4 a0 = acc[ai][bj][m][0], a1 = acc[ai][bj][m][1]; float o[8]; const float av[8] = {a0[0], a0[1], a0[2], a0[3], a1[0], a1[1], a1[2], a1[3]};
#pragma unroll
                        for (int j = 0; j < 4; ++j) { const unsigned gw = gv[mm][bj][j], tw = tv[mm][bj][j];
                            o[2 * j] = bflo(tw) + sigmoidf_(bflo(gw)) * av[2 * j]; o[2 * j + 1] = bfhi(tw) + sigmoidf_(bfhi(gw)) * av[2 * j + 1]; }
                        u32x4 w; w.x = cvt_pk_bf16(o[0], o[1]); w.y = cvt_pk_bf16(o[2], o[3]); w.z = cvt_pk_bf16(o[4], o[5]); w.w = cvt_pk_bf16(o[6], o[7]);
                        *(u32x4*)(op + (size_t)ro * DM + bj * HALF) = w; }
                asm volatile("" ::: "memory"); }
    }
};
struct EpiOut {
    static constexpr bool PERM = false;
    const float* XinP; const float* XinS; float* Xout; bf16_t* XB; float* rsp;
    __device__ __forceinline__ void operator()(const f32x4 (&acc)[2][2][4][2], const Unit& u, int wr, int wc, int fr, int fq) const {
        const int row0 = u.pm * BM + wr * 64 + fr, col0 = u.pn * BM + wc * 32 + 4 * fq;
#pragma unroll
        for (int ai = 0; ai < 2; ++ai) {
            f32x4 xi[4][2][2];
#pragma unroll
            for (int m = 0; m < 4; ++m) { const int row = row0 + ai * HALF + m * 16; const float* xin = (row < MP ? XinP + (size_t)row * DM : XinS + (size_t)(row - MP) * DM) + col0;
#pragma unroll
                for (int bj = 0; bj < 2; ++bj)
#pragma unroll
                    for (int n = 0; n < 2; ++n) xi[m][bj][n] = *(const f32x4*)(xin + bj * HALF + n * 16); }
#pragma unroll
            for (int m = 0; m < 4; ++m) { const int row = row0 + ai * HALF + m * 16; const size_t off = (size_t)row * DM + col0; float ss = 0.f;
#pragma unroll
                for (int bj = 0; bj < 2; ++bj)
#pragma unroll
                    for (int n = 0; n < 2; ++n) { const f32x4 xo = xi[m][bj][n] + acc[ai][bj][m][n];
                        *(f32x4*)(Xout + off + bj * HALF + n * 16) = xo; if (XB) { u32x2 w; w.x = cvt_pk_bf16(xo[0], xo[1]); w.y = cvt_pk_bf16(xo[2], xo[3]); *(u32x2*)(XB + off + bj * HALF + n * 16) = w; }
                        ss += (xo[0] * xo[0] + xo[1] * xo[1]) + (xo[2] * xo[2] + xo[3] * xo[3]); }
                ss += __shfl_xor(ss, 16); ss += __shfl_xor(ss, 32);
                if (fq == 0) rsp[(size_t)row * 32 + u.pn * 4 + wc] = ss; } }
    }
};

template <class Epi, int NZ = 1, bool ALIGN_EPI = true, bool SP2 = true>
__device__ __forceinline__ void gemm_phase(LAS unsigned char* lds, const int tid, const Gemm g, const StaticOrder<NZ>& S, const Epi& E) {
    const int wid = __builtin_amdgcn_readfirstlane(tid >> 6), lane = tid & 63, wr = wid >> 2, wc = wid & 3, fr = lane & 15, fq = lane >> 4;
    const int K = g.K, nt = K / BK;
    unsigned voffA[2], voffB[2];
#pragma unroll
    for (int i = 0; i < 2; ++i) { int R, C; stage_rc(tid * 16 + i * 8192, R, C); const int Rb = Epi::PERM ? ((R & ~31) + perm32(R & 31)) : R;
        voffA[i] = (unsigned)(R * K + C) * 2u; voffB[i] = (unsigned)(Rb * K + C) * 2u; }
    const size_t kstep = (size_t)(BK * 2);
    const size_t hstep = (size_t)HALF * K * 2;
    const size_t tstep = 2 * hstep;
    const unsigned ldsw = (unsigned)wid * 1024u;
    const int aoff = lds_byte(wr * 64 + fr, fq * 8), boff = lds_byte(wc * 32 + fr, fq * 8);
#define PG8_SA(b, h) (((b) * 2 + (h)) * HTB)
#define PG8_SB(b, h) ((4 + (b) * 2 + (h)) * HTB)
#define PG8_STAGE(bufoff, gbase, voff) do { _Pragma("unroll") for (int _i = 0; _i < 2; ++_i) \
        __builtin_amdgcn_global_load_lds((const unsigned*)((const char*)(gbase) + (voff)[_i]), (LAS unsigned*)(lds + (bufoff) + ldsw + _i * 8192), 16, 0, 0); } while (0)
#define PG8_LDA(dst, b, h) do { _Pragma("unroll") for (int m = 0; m < 4; ++m) _Pragma("unroll") for (int k = 0; k < 2; ++k) dst[m][k] = *(const LAS bf16x8*)(lds + PG8_SA(b, h) + aoff + m * 2048 + k * 1024); } while (0)
#define PG8_LDB(dst, b, h) do { _Pragma("unroll") for (int n = 0; n < 2; ++n) _Pragma("unroll") for (int k = 0; k < 2; ++k) dst[n][k] = *(const LAS bf16x8*)(lds + PG8_SB(b, h) + boff + n * 2048 + k * 1024); } while (0)
#define PG8_MMA(ai, bj, At, Bt) do { __builtin_amdgcn_s_setprio(1); _Pragma("unroll") for (int m = 0; m < 4; ++m) _Pragma("unroll") for (int n = 0; n < 2; ++n) _Pragma("unroll") for (int k = 0; k < 2; ++k) \
        acc[ai][bj][m][n] = __builtin_amdgcn_mfma_f32_16x16x32_bf16(Bt[n][k], At[m][k], acc[ai][bj][m][n], 0, 0, 0); __builtin_amdgcn_s_setprio(0); } while (0)
#define PG8_WAIT_V(n) asm volatile("s_waitcnt vmcnt(" #n ")" ::: "memory")
#define PG8_WAIT_L(n) asm volatile("s_waitcnt lgkmcnt(" #n ")" ::: "memory")
#define PG8_BAR __builtin_amdgcn_s_barrier()
#define PG8_SCHED __builtin_amdgcn_sched_barrier(0)
    Unit cur, nxt; int ui = 0;
    if (!S.next(0, cur)) return;
    f32x4 acc[2][2][4][2];
#pragma unroll
    for (int a = 0; a < 2; ++a)
#pragma unroll
        for (int b = 0; b < 2; ++b)
#pragma unroll
            for (int m = 0; m < 4; ++m)
#pragma unroll
                for (int n = 0; n < 2; ++n) acc[a][b][m][n] = (f32x4){0.f, 0.f, 0.f, 0.f};
    bf16x8 At[4][2], B0[2][2], B1[2][2];
    const char* cA = selA<NZ>(g, cur.z) + (size_t)cur.pm * tstep; const char* cB = selB<NZ>(g, cur.z) + (size_t)cur.pn * tstep;
    if constexpr (SP2) {
        PG8_STAGE(PG8_SB(0, 0), cB, voffB); PG8_STAGE(PG8_SB(0, 1), cB + hstep, voffB); PG8_STAGE(PG8_SA(0, 0), cA, voffA); PG8_STAGE(PG8_SA(0, 1), cA + hstep, voffA);
        if (wr == 1) PG8_BAR;
        PG8_WAIT_V(2); PG8_BAR;
        PG8_STAGE(PG8_SB(1, 0), cB + kstep, voffB); PG8_STAGE(PG8_SA(1, 0), cA + kstep, voffA); PG8_STAGE(PG8_SB(1, 1), cB + hstep + kstep, voffB);
        PG8_WAIT_V(6); PG8_BAR;
    } else {
        PG8_STAGE(PG8_SB(0, 0), cB, voffB); PG8_STAGE(PG8_SA(0, 0), cA, voffA); PG8_STAGE(PG8_SB(0, 1), cB + hstep, voffB); PG8_STAGE(PG8_SA(0, 1), cA + hstep, voffA);
        if (wr == 1) PG8_BAR;
        PG8_WAIT_V(4); PG8_BAR;
        PG8_STAGE(PG8_SB(1, 0), cB + kstep, voffB); PG8_STAGE(PG8_SA(1, 0), cA + kstep, voffA); PG8_STAGE(PG8_SB(1, 1), cB + hstep + kstep, voffB);
        PG8_WAIT_V(6); PG8_BAR;
    }
    for (;;) {
        const bool has_next = S.next(ui + 1, nxt);
        const char* nA = has_next ? selA<NZ>(g, nxt.z) + (size_t)nxt.pm * tstep : cA; const char* nB = has_next ? selB<NZ>(g, nxt.z) + (size_t)nxt.pn * tstep : cB;
        for (int t = 0; t < nt; t += 2) {
            const bool last = (t == nt - 2);
            const char* a1 = cA + (size_t)(t + 1) * kstep;
            const char* a2 = last ? nA : cA + (size_t)(t + 2) * kstep; const char* b2 = last ? nB : cB + (size_t)(t + 2) * kstep;
            const char* a3 = a2 + kstep; const char* b3 = b2 + kstep;
            if constexpr (SP2) {
            PG8_LDB(B0, 0, 0); PG8_LDB(B1, 0, 1); PG8_SCHED; PG8_LDA(At, 0, 0); PG8_STAGE(PG8_SA(1, 1), a1 + hstep, voffA);
            PG8_WAIT_V(8); PG8_WAIT_L(0); PG8_BAR; PG8_MMA(0, 0, At, B0); PG8_MMA(0, 1, At, B1); PG8_BAR; PG8_SCHED;
            PG8_LDA(At, 0, 1); PG8_STAGE(PG8_SB(0, 0), b2, voffB); PG8_STAGE(PG8_SB(0, 1), b2 + hstep, voffB); PG8_STAGE(PG8_SA(0, 0), a2, voffA);
            PG8_WAIT_V(8); PG8_WAIT_L(0); PG8_BAR; PG8_MMA(1, 0, At, B0); PG8_MMA(1, 1, At, B1); PG8_BAR; PG8_SCHED;
            PG8_LDB(B0, 1, 0); PG8_LDB(B1, 1, 1); PG8_SCHED; PG8_LDA(At, 1, 0); PG8_STAGE(PG8_SA(0, 1), a2 + hstep, voffA);
            PG8_WAIT_V(8); PG8_WAIT_L(0); PG8_BAR; PG8_MMA(0, 0, At, B0); PG8_MMA(0, 1, At, B1); PG8_BAR; PG8_SCHED;
            PG8_LDA(At, 1, 1); PG8_STAGE(PG8_SB(1, 0), b3, voffB); PG8_STAGE(PG8_SB(1, 1), b3 + hstep, voffB); PG8_STAGE(PG8_SA(1, 0), a3, voffA);
            PG8_WAIT_V(8); PG8_WAIT_L(0); PG8_BAR; PG8_MMA(1, 0, At, B0); PG8_MMA(1, 1, At, B1); PG8_BAR; PG8_SCHED;
            } else {
            PG8_LDB(B0, 0, 0); PG8_SCHED; PG8_LDA(At, 0, 0); PG8_STAGE(PG8_SA(1, 1), a1 + hstep, voffA);
            PG8_WAIT_L(8); PG8_BAR; PG8_WAIT_L(0); PG8_MMA(0, 0, At, B0); PG8_BAR; PG8_SCHED;
            PG8_LDB(B1, 0, 1); PG8_STAGE(PG8_SB(0, 0), b2, voffB);
            PG8_BAR; PG8_WAIT_L(0); PG8_MMA(0, 1, At, B1); PG8_BAR;
            PG8_LDA(At, 0, 1); PG8_STAGE(PG8_SA(0, 0), a2, voffA);
            PG8_BAR; PG8_WAIT_L(0); PG8_MMA(1, 0, At, B0); PG8_BAR; PG8_SCHED;
            PG8_STAGE(PG8_SB(0, 1), b2 + hstep, voffB);
            PG8_WAIT_V(6); PG8_BAR; PG8_MMA(1, 1, At, B1); PG8_BAR;
            PG8_LDB(B0, 1, 0); PG8_SCHED; PG8_LDA(At, 1, 0); PG8_STAGE(PG8_SA(0, 1), a2 + hstep, voffA);
            PG8_WAIT_L(8); PG8_BAR; PG8_WAIT_L(0); PG8_MMA(0, 0, At, B0); PG8_BAR; PG8_SCHED;
            PG8_LDB(B1, 1, 1); PG8_STAGE(PG8_SB(1, 0), b3, voffB);
            PG8_BAR; PG8_WAIT_L(0); PG8_MMA(0, 1, At, B1); PG8_BAR;
            PG8_LDA(At, 1, 1); PG8_STAGE(PG8_SA(1, 0), a3, voffA);
            PG8_BAR; PG8_WAIT_L(0); PG8_MMA(1, 0, At, B0); PG8_BAR; PG8_SCHED;
            PG8_STAGE(PG8_SB(1, 1), b3 + hstep, voffB);
            PG8_WAIT_V(6); PG8_BAR; PG8_MMA(1, 1, At, B1); PG8_BAR;
            }
        }
        if constexpr (ALIGN_EPI) { if (wr == 0) PG8_BAR; }
        E(acc, cur, wr, wc, fr, fq);
        if (!has_next) break;
#pragma unroll
        for (int a = 0; a < 2; ++a)
#pragma unroll
            for (int b = 0; b < 2; ++b)
#pragma unroll
                for (int m = 0; m < 4; ++m)
#pragma unroll
                    for (int n = 0; n < 2; ++n) acc[a][b][m][n] = (f32x4){0.f, 0.f, 0.f, 0.f};
        cur = nxt; cA = nA; cB = nB; ++ui;
        if constexpr (ALIGN_EPI) { if (wr == 1) PG8_BAR; }
    }
    PG8_WAIT_V(0);
    if constexpr (!ALIGN_EPI) { if (wr == 0) PG8_BAR; }
    PG8_BAR;
#undef PG8_SA
#undef PG8_SB
#undef PG8_STAGE
#undef PG8_LDA
#undef PG8_LDB
#undef PG8_MMA
#undef PG8_WAIT_V
#undef PG8_WAIT_L
#undef PG8_BAR
#undef PG8_SCHED
}
}

constexpr int NWAVES = 8, NTHR = NWAVES * 64;
constexpr int LDS_BYTES = 147456;
constexpr int LDS_MISC_OFF = 143360;

struct Args { const float* in[32]; float* out; unsigned char* ws; int ph_lo, ph_hi; };

struct Ctx {
    LAS unsigned char* lds;
    int tid, lane, wave, vcu, G, gtid, gthreads, gw, ngw;
    const float* const* in; float* out; unsigned char* ws;
};
__device__ __forceinline__ const float* INP_(const float* const* in, int k) { asm volatile("" : "+s"(k)); return in[k]; }
#define INP(k) INP_(C.in, (k))
#define WSP(T, off) ((T*)(C.ws + (off)))
#define cWIN WSP(bf16_t, WS_WIN)
#define cWGLU WSP(bf16_t, WS_WGLU + (size_t)l * WS_LSTRIDE)
#define cWBR WSP(bf16_t, WS_WBR + (size_t)l * WS_LSTRIDE)
#define cWOUT WSP(bf16_t, WS_WOUT + (size_t)l * WS_LSTRIDE)
#define cMERGED WSP(bf16_t, WS_MERGED)
#define cPROJ WSP(bf16_t, WS_PROJ)
#define cYS5 WSP(bf16_t, WS_YS5)
#define cAS5 WSP(bf16_t, WS_AS5)
#define cALRU WSP(bf16_t, WS_ALRU)
#define cARET WSP(bf16_t, WS_ARET)
#define cLRUP WSP(bf16_t, WS_LRUP)
#define cXB ((bf16_t*)(C.out + O_XB))
#define cKV WSP(float, WS_KV)
#define cS5E WSP(float, WS_S5E)
#define cS5HIN WSP(float, WS_S5HIN)
#define cRS WSP(float, WS_MISC + MI_RS)
#define cRSP WSP(float, WS_MISC + MI_RSP)
#define cS5LB WSP(float, WS_MISC + MI_S5LB + (size_t)l * 4 * 4096 * 4)
#define cS5BB WSP(float, WS_MISC + MI_S5BB + (size_t)l * 2 * 65536 * 4)
#define cROPE WSP(float, WS_MISC + MI_ROPE)
#define cLSUM WSP(float, WS_MISC + MI_LSUM)
#define cLHIN WSP(float, WS_MISC + MI_LHIN)
#define cWLRU WSP(bf16_t, WS_MISC + MI_WLRU)

constexpr int TT_PITCH = 257;
__device__ __forceinline__ void transpose_tile(Ctx& C, const float* W, int K, int N, bf16_t* WT, const float* gk, int item) {
    LAS float* scr = (LAS float*)C.lds;
    const int nblk = N / 256, kb = item / nblk, nb = item % nblk, k0 = 64 * kb, n0 = 256 * nb;
    __syncthreads();
    { const int r = C.tid >> 6, c4 = (C.tid & 63) * 4; f32x4 v[8];
#pragma unroll
      for (int i = 0; i < 8; ++i) v[i] = *(const f32x4*)(W + (size_t)(k0 + r + 8 * i) * N + n0 + c4);
#pragma unroll
      for (int i = 0; i < 8; ++i) { const float g = gk ? gk[k0 + r + 8 * i] : 1.0f; LAS float* d = scr + (r + 8 * i) * TT_PITCH + c4; d[0] = v[i][0] * g; d[1] = v[i][1] * g; d[2] = v[i][2] * g; d[3] = v[i][3] * g; } }
    __syncthreads();
    { const int c = C.tid & 7;
#pragma unroll
      for (int j = 0; j < 4; ++j) { const int n = (C.tid >> 3) + 64 * j; const LAS float* s = scr + (8 * c) * TT_PITCH + n;
          u32x4 o; o.x = pk2(s[0 * TT_PITCH], s[1 * TT_PITCH]); o.y = pk2(s[2 * TT_PITCH], s[3 * TT_PITCH]); o.z = pk2(s[4 * TT_PITCH], s[5 * TT_PITCH]); o.w = pk2(s[6 * TT_PITCH], s[7 * TT_PITCH]);
          *(u32x4*)(WT + (size_t)(n0 + n) * K + k0 + 8 * c) = o; } }
}
constexpr int TI_IN = (DM / 64) * (NIN / 256), TI_GLU = (1024 / 64) * (1024 / 256), TI_BR = (1024 / 64) * (DM / 256), TI_OUT = (DM / 64) * (DM / 256), TI_SMALL = TI_GLU + 3 * TI_BR + TI_OUT;
__device__ __forceinline__ void convert_win(Ctx& C, int l) {
    const float* w = INP(8) + (size_t)l * DM * NIN; const float* g = INP(7) + l * DM;
    for (int it = C.vcu; it < TI_IN; it += C.G) transpose_tile(C, w, DM, NIN, cWIN, g, it);
    __syncthreads();
}
__device__ __forceinline__ void convert_small(Ctx& C, int l) {
    const float* in17 = INP(17); const float* in27 = INP(27); const float* in28 = INP(28); const float* in29 = INP(29); const float* in30 = INP(30);
    for (int it = C.vcu; it < TI_SMALL; it += C.G) {
        int r = it;
        if (r < TI_GLU) { transpose_tile(C, in17 + (size_t)l * 1024 * 1024, 1024, 1024, cWGLU, nullptr, r); continue; } r -= TI_GLU;
        if (r < TI_BR) { transpose_tile(C, in27 + (size_t)l * 1024 * DM, 1024, DM, cWBR, nullptr, r); continue; } r -= TI_BR;
        if (r < TI_BR) { transpose_tile(C, in28 + (size_t)l * 1024 * DM, 1024, DM, cWBR + (size_t)DM * 1024, nullptr, r); continue; } r -= TI_BR;
        if (r < TI_BR) { transpose_tile(C, in29 + (size_t)l * 1024 * DM, 1024, DM, cWBR + (size_t)2 * DM * 1024, nullptr, r); continue; } r -= TI_BR;
        transpose_tile(C, in30 + (size_t)l * DM * DM, DM, DM, cWOUT, nullptr, r);
    }
    __syncthreads();
}
__device__ __forceinline__ void s5_params(Ctx& C, int l) {
    const float* in9 = INP(9); const float* in10 = INP(10); const float* in11 = INP(11); const float* in12 = INP(12); const float* in13 = INP(13);
    for (int i = C.gtid; i < S5G * S5P; i += C.gthreads) {
        const int g = i >> 6;
        const float dt = expf(in11[l * S5G + g]), lr = in9[l * 4096 + i], li = in10[l * 4096 + i];
        const float a = lr * dt, b = li * dt, ea = expf(a), cb = cosf(b), sb = sinf(b), sh = sinf(0.5f * b);
        const float lbr = ea * cb, lbi = ea * sb;
        const float nr = expm1f(a) * cb - 2.0f * sh * sh, ni = ea * sb, den = lr * lr + li * li;
        const float cr = (nr * lr + ni * li) / den, ci = (ni * lr - nr * li) / den;
        cS5LB[i] = lbr; cS5LB[4096 + i] = lbi;
        float pr = lbr, pi = lbi;
#pragma unroll
        for (int s = 0; s < 6; ++s) { const float t = pr * pr - pi * pi; pi = 2.0f * pr * pi; pr = t; }
        cS5LB[8192 + i] = pr; cS5LB[12288 + i] = pi;
        const float* bre = in12 + ((size_t)l * 4096 + i) * 16; const float* bim = in13 + ((size_t)l * 4096 + i) * 16;
#pragma unroll
        for (int c = 0; c < 16; ++c) { const float br = bre[c], bi = bim[c]; cS5BB[(size_t)i * 16 + c] = cr * br - ci * bi; cS5BB[65536 + (size_t)i * 16 + c] = cr * bi + ci * br; }
    }
}
__device__ __forceinline__ void phase_prep(Ctx& C, int l) {
    if (l == 0) {
        convert_win(C, 0); convert_small(C, 0); convert_small(C, 1); s5_params(C, 0); s5_params(C, 1);
        { const float* in21 = INP(21); const float* in23 = INP(23);
          for (int i = C.gtid; i < 2 * 8 * 256 * 128; i += C.gthreads) { const int c = i & 127, r = (i >> 7) & 255, ln = i >> 15, gate = r >> 7, d = r & 127;
              cWLRU[i] = (bf16_t)f2bf((gate ? in23 : in21)[(size_t)ln * 16384 + c * 128 + d]); } }
        const float* in0 = INP(0); const float* in1 = INP(1);
        for (int m = C.gw; m < M; m += C.ngw) {
            const float* xr = (m < MP) ? in0 + (size_t)m * DM : in1 + (size_t)(m - MP) * DM;
            float ss = 0.f;
#pragma unroll
            for (int j = 0; j < 8; ++j) { const f32x4 v = *(const f32x4*)(xr + 4 * C.lane + 256 * j); ss += (v[0] * v[0] + v[1] * v[1]) + (v[2] * v[2] + v[3] * v[3]);
                u32x2 w; w.x = pk2(v[0], v[1]); w.y = pk2(v[2], v[3]); *(u32x2*)(cXB + (size_t)m * DM + 4 * C.lane + 256 * j) = w; }
            ss = wave_sum(ss);
            if (C.lane == 0) cRS[m] = 1.0f / sqrtf(ss * (1.0f / DM) + NORM_EPS);
        }
        for (int i = C.gtid; i < 2056 * 64; i += C.gthreads) {
            const int pi_ = i >> 6, j = i & 63; const int pos = pi_ < 2048 ? pi_ : PAST + (pi_ - 2048);
            const float freq = powf(10000.0f, -(float)j / 64.0f); const float ang = (float)pos * freq;
            double r = (double)ang; const double k = rint(r * 0.15915494309189535); r -= k * 6.283185307179586;
            const float rr = (float)r;
            cROPE[i] = cosf(rr); cROPE[2056 * 64 + i] = sinf(rr);
        }
    } else {
        for (int m = C.gtid; m < M; m += C.gthreads) { float ss = 0.f;
#pragma unroll
            for (int j = 0; j < 8; ++j) { const f32x4 v = *(const f32x4*)(cRSP + (size_t)m * 32 + 4 * j); ss += (v[0] + v[1]) + (v[2] + v[3]); }
            cRS[m] = 1.0f / sqrtf(ss * (1.0f / DM) + NORM_EPS); }
    }
}

constexpr int TP = 136;
constexpr int S5_BUP = 132;
struct S5Frags { bf16x8 bb[8]; float lbr, lbi; };
__device__ __forceinline__ void s5_load_bb(Ctx& C, int l, int g, S5Frags& F) {
    const int fr = C.lane & 15, tq = C.lane >> 4;
#pragma unroll
    for (int nt = 0; nt < 8; ++nt) { bf16x8 v = (bf16x8){0, 0, 0, 0, 0, 0, 0, 0};
        if (tq < 2) { const int pp = nt * 16 + fr; const float* s = cS5BB + (pp >= 64 ? 65536 : 0) + ((size_t)(g * 64 + (pp & 63))) * 16 + 8 * tq;
            const f32x4 a = *(const f32x4*)s, b = *(const f32x4*)(s + 4); u32x4 w; w.x = pk2(a[0], a[1]); w.y = pk2(a[2], a[3]); w.z = pk2(b[0], b[1]); w.w = pk2(b[2], b[3]); v = __builtin_bit_cast(bf16x8, w); }
        F.bb[nt] = v; }
    F.lbr = cS5LB[g * 64 + C.lane]; F.lbi = cS5LB[4096 + g * 64 + C.lane];
}
__device__ __forceinline__ void s5_decode(int it, int& g, int& k) { g = (it & 255) >> 2; k = ((it & 3) << 2) | (it >> 8); }
__device__ __forceinline__ bf16x8 s5_load_u(Ctx& C, size_t row, int g, int nts) {
    const int fr = C.lane & 15, tq = C.lane >> 4; bf16x8 ua = (bf16x8){0, 0, 0, 0, 0, 0, 0, 0};
    if (tq < 2 && fr < nts) ua = *(const bf16x8*)(cPROJ + (row + fr) * NIN + C_US5 + g * 16 + 8 * tq);
    return ua;
}
template <bool WRITE_H>
__device__ __forceinline__ void s5_subblock(Ctx& C, const S5Frags& F, const bf16x8 ua, int nts, LAS float* BUf, LAS bf16_t* Hb, float& hr, float& hi) {
    const int fr = C.lane & 15, tq = C.lane >> 4;
#pragma unroll
    for (int nt = 0; nt < 8; ++nt) { f32x4 d = __builtin_amdgcn_mfma_f32_16x16x32_bf16(ua, F.bb[nt], (f32x4){0.f, 0.f, 0.f, 0.f}, 0, 0, 0);
#pragma unroll
        for (int r = 0; r < 4; ++r) BUf[(tq * 4 + r) * S5_BUP + nt * 16 + fr] = d[r]; }
    LDS_WAIT(); asm volatile("" ::: "memory");
    const int p = C.lane;
#pragma unroll 4
    for (int t = 0; t < nts; ++t) { const float br = BUf[t * S5_BUP + p], bi = BUf[t * S5_BUP + 64 + p];
        const float nr = F.lbr * hr - F.lbi * hi + br, ni = F.lbr * hi + F.lbi * hr + bi; hr = nr; hi = ni;
        if (WRITE_H) { Hb[t * TP + p] = (bf16_t)f2bf(hr); Hb[t * TP + 64 + p] = (bf16_t)f2bf(hi); } }
    LDS_WAIT(); asm volatile("" ::: "memory");
}
__device__ __forceinline__ void s5_pass1(Ctx& C, int l) {
    LAS float* BUf = (LAS float*)(C.lds + C.wave * 12800); LAS bf16_t* Hb = (LAS bf16_t*)(BUf + 16 * S5_BUP);
    int cur_g = -1; S5Frags F; bf16x8 un[4];
    { int g, k; if (C.vcu < 1024) { s5_decode(C.vcu, g, k); const int pair = k * 8 + C.wave; const size_t row0 = (size_t)(pair >> 5) * SEQ + (pair & 31) * S5L;
#pragma unroll
        for (int s = 0; s < 4; ++s) un[s] = s5_load_u(C, row0 + 16 * s, g, 16); } }
    for (int it = C.vcu; it < 1024; it += C.G) {
        int g, k; s5_decode(it, g, k); const int pair = k * 8 + C.wave, b = pair >> 5, j = pair & 31;
        { s5_load_bb(C, l, g, F); cur_g = g; }
        bf16x8 uc[4];
#pragma unroll
        for (int s = 0; s < 4; ++s) uc[s] = un[s];
        if (it + C.G < 1024) { int g2, k2; s5_decode(it + C.G, g2, k2); const int pr2 = k2 * 8 + C.wave; const size_t r2 = (size_t)(pr2 >> 5) * SEQ + (pr2 & 31) * S5L;
#pragma unroll
            for (int s = 0; s < 4; ++s) un[s] = s5_load_u(C, r2 + 16 * s, g2, 16); }
        float hr = 0.f, hi = 0.f;
#pragma unroll
        for (int s = 0; s < 4; ++s) s5_subblock<false>(C, F, uc[s], 16, BUf, Hb, hr, hi);
        const size_t o = ((size_t)(b * S5NCH + j) * 64 + g) * 128 + C.lane; cS5E[o] = hr; cS5E[o + 64] = hi;
    }
}
__device__ __forceinline__ void s5_carry(Ctx& C, int l) {
    for (int i = C.gtid; i < NB * S5G * S5P; i += C.gthreads) {
        const int b = i >> 12, gp = i & 4095, g = gp >> 6, p = gp & 63;
        const float l64r = cS5LB[8192 + gp], l64i = cS5LB[12288 + gp]; float rr = 0.f, ri = 0.f;
        const size_t o0 = ((size_t)(b * S5NCH) * 64 + g) * 128 + p;
#pragma unroll 1
        for (int jb = 0; jb < S5NCH; jb += 8) { float er[8], ei[8]; const float* e = cS5E + o0 + (size_t)jb * 8192; float* hn = cS5HIN + o0 + (size_t)jb * 8192;
#pragma unroll
            for (int j = 0; j < 8; ++j) { er[j] = e[(size_t)j * 8192]; ei[j] = e[(size_t)j * 8192 + 64]; }
#pragma unroll
            for (int j = 0; j < 8; ++j) { hn[(size_t)j * 8192] = rr; hn[(size_t)j * 8192 + 64] = ri;
                const float nr = l64r * rr - l64i * ri + er[j], ni = l64r * ri + l64i * rr + ei[j]; rr = nr; ri = ni; } }
        C.out[O_S5RP + (size_t)(l * NB + b) * 4096 + gp] = rr; C.out[O_S5IP + (size_t)(l * NB + b) * 4096 + gp] = ri;
    }
}
__device__ __forceinline__ void s5_pass2(Ctx& C, int l) {
    const float* in2 = INP(2); const float* in3 = INP(3); const float* in14 = INP(14); const float* in15 = INP(15); const float* in16 = INP(16);
    LAS float* BUf = (LAS float*)(C.lds + C.wave * 12800); LAS bf16_t* Hb = (LAS bf16_t*)(BUf + 16 * S5_BUP);
    const int fr = C.lane & 15, tq = C.lane >> 4, p = C.lane;
    int cur_g = -1; S5Frags F; bf16x8 ct[4], dd; bf16x8 un[4];
    auto rows_of = [&](int it, int& g, size_t& row0, int& ntok, int& pair) { const bool smp = it >= 1024; int k; s5_decode(smp ? it - 1024 : it, g, k); pair = k * 8 + C.wave;
        if (smp) { row0 = (size_t)MP + pair * DS; ntok = DS; } else { row0 = (size_t)(pair >> 5) * SEQ + (pair & 31) * S5L; ntok = S5L; } };
    if (C.vcu < 2048) { int g; size_t row0; int ntok, pair; rows_of(C.vcu, g, row0, ntok, pair);
#pragma unroll
        for (int s = 0; s < 4; ++s) un[s] = (16 * s < ntok) ? s5_load_u(C, row0 + 16 * s, g, ntok - 16 * s < 16 ? ntok - 16 * s : 16) : (bf16x8){0, 0, 0, 0, 0, 0, 0, 0}; }
    for (int it = C.vcu; it < 2048; it += C.G) {
        const bool smp = it >= 1024; int g; size_t row0; int ntok, pair; rows_of(it, g, row0, ntok, pair);
        s5_load_bb(C, l, g, F);
        if (g != cur_g) { cur_g = g;
#pragma unroll
            for (int ks = 0; ks < 4; ++ks) { const int pp = ks * 32 + tq * 8; const float* s = (pp >= 64 ? in15 : in14) + ((size_t)(l * S5G + g) * 16 + fr) * 64 + (pp & 63); const float sg = pp >= 64 ? -1.f : 1.f;
                const f32x4 a = *(const f32x4*)s * sg, b = *(const f32x4*)(s + 4) * sg; u32x4 w; w.x = pk2(a[0], a[1]); w.y = pk2(a[2], a[3]); w.z = pk2(b[0], b[1]); w.w = pk2(b[2], b[3]); ct[ks] = __builtin_bit_cast(bf16x8, w); }
            { const unsigned dbits = f2bf(in16[l * 1024 + g * 16 + fr]); u32x4 w = (u32x4){0u, 0u, 0u, 0u};
              if ((fr >> 3) == tq) { const int j = fr & 7; w[j >> 1] = (j & 1) ? (dbits << 16) : dbits; }
              dd = __builtin_bit_cast(bf16x8, w); } }
        bf16x8 uc[4];
#pragma unroll
        for (int s = 0; s < 4; ++s) uc[s] = un[s];
        if (it + C.G < 2048) { int g2; size_t r2; int nt2, pr2; rows_of(it + C.G, g2, r2, nt2, pr2);
#pragma unroll
            for (int s = 0; s < 4; ++s) un[s] = (16 * s < nt2) ? s5_load_u(C, r2 + 16 * s, g2, nt2 - 16 * s < 16 ? nt2 - 16 * s : 16) : (bf16x8){0, 0, 0, 0, 0, 0, 0, 0}; }
        float hr, hi;
        if (smp) { const size_t o = ((size_t)(l * DB + pair) * 64 + g) * 64 + p; hr = in2[o]; hi = in3[o]; }
        else { const int b = pair >> 5, j = pair & 31; const size_t o = ((size_t)(b * S5NCH + j) * 64 + g) * 128 + p; hr = cS5HIN[o]; hi = cS5HIN[o + 64]; }
#pragma unroll
        for (int s = 0; s < 4; ++s) { const int sb = 16 * s; if (sb < ntok) {
            const int nts = (ntok - sb) < 16 ? (ntok - sb) : 16;
            s5_subblock<true>(C, F, uc[s], nts, BUf, Hb, hr, hi);
            f32x4 y = __builtin_amdgcn_mfma_f32_16x16x32_bf16(uc[s], dd, (f32x4){0.f, 0.f, 0.f, 0.f}, 0, 0, 0);
#pragma unroll
            for (int ks = 0; ks < 4; ++ks) { const bf16x8 a = *(const LAS bf16x8*)(Hb + fr * TP + ks * 32 + tq * 8); y = __builtin_amdgcn_mfma_f32_16x16x32_bf16(a, ct[ks], y, 0, 0, 0); }
#pragma unroll
            for (int r = 0; r < 4; ++r) { const int tok = tq * 4 + r; if (tok < nts) cYS5[(row0 + sb + tok) * 1024 + g * 16 + fr] = (bf16_t)f2bf(gelu_tanh(y[r])); }
            LDS_WAIT(); asm volatile("" ::: "memory"); } }
        if (smp) { const size_t o = ((size_t)(l * DB + pair) * 64 + g) * 64 + p; C.out[O_S5RS + o] = hr; C.out[O_S5IS + o] = hi; }
    }
}
constexpr int XP = 132;
__device__ __forceinline__ void lru_tiles(Ctx& C, int l) {
    const float* in4 = INP(4); const float* in5 = INP(5); const float* in19 = INP(19); const float* in20 = INP(20); const float* in22 = INP(22); const float* in24 = INP(24); const float* in25 = INP(25);
    LAS bf16_t* WT = (LAS bf16_t*)C.lds;
    LAS bf16_t* XCb = WT + 256 * TP;
    LAS float* XCf = (LAS float*)(C.lds + (256 + 64) * TP * 2);
    constexpr int NTILES = MP / LT + MS / LT;
    int cur_n = -1; float ba_ = 0.f, bx_ = 0.f, sp = 0.f;
    for (int it = C.vcu; it < NTILES * 8; it += C.G) {
        const int n = it & 7, tile = it >> 3; const bool smp = tile >= MP / LT;
        const size_t row0 = (size_t)tile * LT;
        __syncthreads();
        if (n != cur_n) { cur_n = n; const bf16_t* wsrc = cWLRU + (size_t)(l * 8 + n) * 256 * 128;
            { const int chh = n * 128 + 16 * C.wave + (C.lane & 15); ba_ = in22[l * 1024 + chh]; bx_ = in24[l * 1024 + chh]; sp = log1pf(expf(-in25[l * 1024 + chh])); }
#pragma unroll
            for (int i = 0; i < 8; ++i) { const int ch = C.tid + NTHR * i, r = ch >> 4, c8 = (ch & 15) * 8; *(LAS u32x4*)(WT + r * TP + c8) = *(const u32x4*)(wsrc + r * 128 + c8); } }
        { const int tt = C.tid >> 3, cq = C.tid & 7, ch0 = n * 128 + 16 * cq;
          float xc[16];
#pragma unroll
          for (int c = 0; c < 16; ++c) xc[c] = in20[l * 1024 + ch0 + c];
          const int s = smp ? (tt & 7) : ((tile & (LNT - 1)) * LT + tt);
          const int bs = smp ? (tile - MP / LT) * 8 + (tt >> 3) : 0;
#pragma unroll
          for (int k = 0; k < 4; ++k) { const int sr = s - 3 + k; float u[16];
              if (sr >= 0) { const bf16_t* src = cPROJ + (row0 + tt - 3 + k) * NIN + C_ULRU + ch0; const u32x4 v0 = *(const u32x4*)src, v1 = *(const u32x4*)(src + 8);
#pragma unroll
                  for (int j = 0; j < 4; ++j) { u[2 * j] = bflo(v0[j]); u[2 * j + 1] = bfhi(v0[j]); u[8 + 2 * j] = bflo(v1[j]); u[9 + 2 * j] = bfhi(v1[j]); } }
              else if (smp) { const float* src = in5 + ((size_t)(l * DB + bs) * 3 + (sr + 3)) * 1024 + ch0;
#pragma unroll
                  for (int j = 0; j < 4; ++j) { const f32x4 v = *(const f32x4*)(src + 4 * j); u[4 * j] = v[0]; u[4 * j + 1] = v[1]; u[4 * j + 2] = v[2]; u[4 * j + 3] = v[3]; } }
              else {
#pragma unroll
                  for (int c = 0; c < 16; ++c) u[c] = 0.f; }
              const float* cw = in19 + (size_t)(l * 4 + k) * 1024 + ch0;
#pragma unroll
              for (int c = 0; c < 16; ++c) xc[c] += cw[c] * u[c]; }
#pragma unroll
          for (int j = 0; j < 4; ++j) *(LAS f32x4*)(XCf + tt * XP + 16 * cq + 4 * j) = (f32x4){xc[4 * j], xc[4 * j + 1], xc[4 * j + 2], xc[4 * j + 3]};
          u32x4 w0, w1;
#pragma unroll
          for (int j = 0; j < 4; ++j) { w0[j] = pk2(xc[2 * j], xc[2 * j + 1]); w1[j] = pk2(xc[8 + 2 * j], xc[9 + 2 * j]); }
          *(LAS u32x4*)(XCb + tt * TP + 16 * cq) = w0; *(LAS u32x4*)(XCb + tt * TP + 16 * cq + 8) = w1; }
        __syncthreads();
        const int fr = C.lane & 15, tq = C.lane >> 4, d = 16 * C.wave + fr, ch = n * 128 + d;
        f32x4 pa[4], px[4];
#pragma unroll
        for (int mt = 0; mt < 4; ++mt) { pa[mt] = (f32x4){0.f, 0.f, 0.f, 0.f}; px[mt] = (f32x4){0.f, 0.f, 0.f, 0.f}; }
#pragma unroll
        for (int k = 0; k < 4; ++k) { const bf16x8 ba = *(const LAS bf16x8*)(WT + d * TP + k * 32 + tq * 8), bx = *(const LAS bf16x8*)(WT + (128 + d) * TP + k * 32 + tq * 8);
#pragma unroll
            for (int mt = 0; mt < 4; ++mt) { const bf16x8 a = *(const LAS bf16x8*)(XCb + (mt * 16 + fr) * TP + k * 32 + tq * 8);
                pa[mt] = __builtin_amdgcn_mfma_f32_16x16x32_bf16(a, ba, pa[mt], 0, 0, 0); px[mt] = __builtin_amdgcn_mfma_f32_16x16x32_bf16(a, bx, px[mt], 0, 0, 0); } }
#pragma unroll
        for (int mt = 0; mt < 4; ++mt)
#pragma unroll
            for (int r = 0; r < 4; ++r) { const float rg = sigmoidf_(pa[mt][r] + ba_), ig = sigmoidf_(px[mt][r] + bx_), la = -8.0f * rg * sp, a = __builtin_amdgcn_exp2f(1.4426950408889634f * la);
                const float x2 = 2.0f * la, om = -x2 * (1.0f + x2 * (0.5f + x2 * (0.16666667f + x2 * (0.041666668f + x2 * (0.0083333333f + x2 * 0.0013888889f)))));
                const float xv = XCf[(mt * 16 + tq * 4 + r) * XP + d]; pa[mt][r] = a; px[mt][r] = __builtin_amdgcn_sqrtf(fmaxf(om, 0.f)) * (ig * xv); }
        float RA = 1.f, RB = 0.f;
        if (!smp) {
#pragma unroll
            for (int mt = 0; mt < 4; ++mt) {
                float cA = 1.f, cB = 0.f;
#pragma unroll
                for (int r = 0; r < 4; ++r) { cB = pa[mt][r] * cB + px[mt][r]; cA *= pa[mt][r]; px[mt][r] = cB; pa[mt][r] = cA; }
                float iA = cA, iB = cB;
                { const float pA = __shfl_up(iA, 16), pB = __shfl_up(iB, 16); if (tq >= 1) { iB = iA * pB + iB; iA = iA * pA; } }
                { const float pA = __shfl_up(iA, 32), pB = __shfl_up(iB, 32); if (tq >= 2) { iB = iA * pB + iB; iA = iA * pA; } }
                float eA = __shfl_up(iA, 16), eB = __shfl_up(iB, 16); if (tq == 0) { eA = 1.f; eB = 0.f; }
                const float inB = eA * RB + eB, inA = eA * RA;
#pragma unroll
                for (int r = 0; r < 4; ++r) { px[mt][r] += pa[mt][r] * inB; pa[mt][r] *= inA; }
                const float tA = __shfl(iA, fr + 48), tB = __shfl(iB, fr + 48);
                RB = tA * RB + tB; RA = RA * tA;
            }
            if (tq == 3) { cLSUM[((size_t)tile * 1024 + ch) * 2] = RA; cLSUM[((size_t)tile * 1024 + ch) * 2 + 1] = RB;
                if ((tile & (LNT - 1)) == LNT - 1) { const int b = tile / LNT;
#pragma unroll
                    for (int k = 0; k < 3; ++k) C.out[O_CONVP + ((size_t)(l * NB + b) * 3 + k) * 1024 + ch] = bf2f(cPROJ[(row0 + 61 + k) * NIN + C_ULRU + ch]); } }
        } else {
#pragma unroll
            for (int mt = 0; mt < 4; ++mt) { const int bs = (tile - MP / LT) * 8 + 2 * mt + (tq >> 1);
                float cA = 1.f, cB = 0.f;
#pragma unroll
                for (int r = 0; r < 4; ++r) { cB = pa[mt][r] * cB + px[mt][r]; cA *= pa[mt][r]; px[mt][r] = cB; pa[mt][r] = cA; }
                const float h0 = in4[(size_t)(l * DB + bs) * 1024 + ch];
                const float pA = __shfl_up(cA, 16), pB = __shfl_up(cB, 16);
                const float hin = (tq & 1) ? (pA * h0 + pB) : h0;
#pragma unroll
                for (int r = 0; r < 4; ++r) { px[mt][r] += pa[mt][r] * hin; pa[mt][r] = 0.f; }
                if (tq & 1) { C.out[O_LRUS + (size_t)(l * DB + bs) * 1024 + ch] = px[mt][3];
#pragma unroll
                    for (int k = 0; k < 3; ++k) C.out[O_CONVS + ((size_t)(l * DB + bs) * 3 + k) * 1024 + ch] = bf2f(cPROJ[(row0 + mt * 16 + (tq >> 1) * 8 + 5 + k) * NIN + C_ULRU + ch]); } }
        }
        __syncthreads();
        { LAS bf16_t* HT = XCb; LAS bf16_t* PT = (LAS bf16_t*)XCf;
#pragma unroll
          for (int mt = 0; mt < 4; ++mt)
#pragma unroll
              for (int r = 0; r < 4; ++r) { const int tok = mt * 16 + tq * 4 + r; HT[tok * TP + d] = (bf16_t)f2bf(px[mt][r]); PT[tok * TP + d] = (bf16_t)f2bf(pa[mt][r]); }
          __syncthreads();
#pragma unroll
          for (int i = 0; i < 2; ++i) { const int cidx = C.tid + NTHR * i, tok = cidx >> 4, c8 = (cidx & 15) * 8; const size_t o = (row0 + tok) * 1024 + n * 128 + c8;
              *(u32x4*)(cALRU + o) = *(const LAS u32x4*)(HT + tok * TP + c8); *(u32x4*)(cLRUP + o) = *(const LAS u32x4*)(PT + tok * TP + c8); } }
    }
    __syncthreads();
}
__device__ __forceinline__ void lru_carry(Ctx& C, int l) {
    for (int i = C.gtid; i < NB * 1024; i += C.gthreads) { const int b = i >> 10, ch = i & 1023; float run = 0.f;
#pragma unroll 1
        for (int tb = 0; tb < LNT; tb += 8) { f32x2 pe[8]; const float* s = cLSUM + ((size_t)(b * LNT + tb) * 1024 + ch) * 2; float* hn = cLHIN + (size_t)(b * LNT + tb) * 1024 + ch;
#pragma unroll
            for (int t = 0; t < 8; ++t) pe[t] = *(const f32x2*)(s + (size_t)t * 2048);
#pragma unroll
            for (int t = 0; t < 8; ++t) { hn[(size_t)t * 1024] = run; run = pe[t][0] * run + pe[t][1]; } }
        C.out[O_LRUP + (size_t)(l * NB + b) * 1024 + ch] = run; }
}
__device__ __forceinline__ void lru_fin(Ctx& C) {
    for (int i = C.gtid; i < M * 128; i += C.gthreads) { const int row = i >> 7, c8 = (i & 127) * 8;
        const u32x4 hv = *(const u32x4*)(cALRU + (size_t)row * 1024 + c8), pv = *(const u32x4*)(cLRUP + (size_t)row * 1024 + c8), zv = *(const u32x4*)(cPROJ + (size_t)row * NIN + C_ZLRU + c8);
        f32x4 h0 = (f32x4){0.f, 0.f, 0.f, 0.f}, h1 = h0;
        if (row < MP) { const float* hp = cLHIN + (size_t)(row >> 6) * 1024 + c8; h0 = *(const f32x4*)hp; h1 = *(const f32x4*)(hp + 4); }
        u32x4 w;
        const float hh[8] = {h0[0], h0[1], h0[2], h0[3], h1[0], h1[1], h1[2], h1[3]};
#pragma unroll
        for (int j = 0; j < 4; ++j) {
            const float ya = bflo(hv[j]) + bflo(pv[j]) * hh[2 * j], yb = bfhi(hv[j]) + bfhi(pv[j]) * hh[2 * j + 1];
            w[j] = pk2(ya * siluf_(bflo(zv[j])), yb * siluf_(bfhi(zv[j]))); }
        *(u32x4*)(cALRU + (size_t)row * 1024 + c8) = w; }
}

__device__ __forceinline__ void wave_mma_128(const LAS bf16_t* A, int arow0, const LAS bf16_t* Bt, f32x4 (&acc)[8], int lane) {
    const int fr = lane & 15, fq = lane >> 4;
#pragma unroll
    for (int k = 0; k < 4; ++k) { const bf16x8 a = *(const LAS bf16x8*)(A + (arow0 + fr) * TP + k * 32 + fq * 8);
#pragma unroll
        for (int nt = 0; nt < 8; ++nt) { const bf16x8 b = *(const LAS bf16x8*)(Bt + (nt * 16 + fr) * TP + k * 32 + fq * 8);
            acc[nt] = __builtin_amdgcn_mfma_f32_16x16x32_bf16(a, b, acc[nt], 0, 0, 0); } }
}
__device__ __forceinline__ float ret_logg(int h) { return log1pf(-exp2f(-5.0f - (float)h)); }
__device__ __forceinline__ void rope_load(Ctx& C, size_t row, int colb, int posidx, int qd, float (&o1)[16], float (&o2)[16]) {
    const bf16_t* src = cPROJ + row * NIN + colb + 16 * qd;
    const u32x4 a0 = *(const u32x4*)src, a1 = *(const u32x4*)(src + 8), b0 = *(const u32x4*)(src + 64), b1 = *(const u32x4*)(src + 72);
    const float* cs = cROPE + (size_t)posidx * 64 + 16 * qd; const float* sn = cs + 2056 * 64;
    float x1[16], x2[16];
#pragma unroll
    for (int j = 0; j < 4; ++j) { x1[2 * j] = bflo(a0[j]); x1[2 * j + 1] = bfhi(a0[j]); x1[8 + 2 * j] = bflo(a1[j]); x1[9 + 2 * j] = bfhi(a1[j]);
        x2[2 * j] = bflo(b0[j]); x2[2 * j + 1] = bfhi(b0[j]); x2[8 + 2 * j] = bflo(b1[j]); x2[9 + 2 * j] = bfhi(b1[j]); }
#pragma unroll
    for (int j = 0; j < 4; ++j) { const f32x4 c = *(const f32x4*)(cs + 4 * j), s = *(const f32x4*)(sn + 4 * j);
#pragma unroll
        for (int k = 0; k < 4; ++k) { o1[4 * j + k] = x1[4 * j + k] * c[k] - x2[4 * j + k] * s[k]; o2[4 * j + k] = x1[4 * j + k] * s[k] + x2[4 * j + k] * c[k]; } }
}
__device__ __forceinline__ void load_vt(Ctx& C, LAS bf16_t* VT, size_t row0, int h) {
    const int tok = C.tid >> 2, qd = C.tid & 3; const bf16_t* src = cPROJ + (row0 + tok) * NIN + C_V + h * 128 + 32 * qd;
#pragma unroll
    for (int j = 0; j < 4; ++j) { const u32x4 v = *(const u32x4*)(src + 8 * j);
#pragma unroll
        for (int k = 0; k < 4; ++k) { VT[(32 * qd + 8 * j + 2 * k) * TP + tok] = (bf16_t)(v[k] & 0xffffu); VT[(32 * qd + 8 * j + 2 * k + 1) * TP + tok] = (bf16_t)(v[k] >> 16); } }
}
__device__ __forceinline__ void ret_pass1(Ctx& C) {
    LAS bf16_t* KT = (LAS bf16_t*)C.lds; LAS bf16_t* VT = KT + 128 * TP;
    for (int it = C.vcu; it < NB * NH * NCH; it += C.G) {
        const int j = it & 15, bh = it >> 4, h = bh & 7, b = bh >> 3; const size_t row0 = (size_t)b * SEQ + j * RC;
        const float lg = ret_logg(h);
        __syncthreads();
        { const int tok = C.tid >> 2, qd = C.tid & 3; float k1[16], k2[16];
          rope_load(C, row0 + tok, C_K + h * 128, j * RC + tok, qd, k1, k2);
          const float sc = 0.08838834764831845f * expf((float)(RC - 1 - tok) * lg);
#pragma unroll
          for (int i = 0; i < 16; ++i) { KT[(16 * qd + i) * TP + tok] = (bf16_t)f2bf(k1[i] * sc); KT[(64 + 16 * qd + i) * TP + tok] = (bf16_t)f2bf(k2[i] * sc); } }
        load_vt(C, VT, row0, h);
        __syncthreads();
        f32x4 acc[8];
#pragma unroll
        for (int nt = 0; nt < 8; ++nt) acc[nt] = (f32x4){0.f, 0.f, 0.f, 0.f};
        wave_mma_128(KT, 16 * C.wave, VT, acc, C.lane);
        float* dst = cKV + (size_t)it * 16384;
#pragma unroll
        for (int nt = 0; nt < 8; ++nt)
#pragma unroll
            for (int r = 0; r < 4; ++r) dst[(16 * C.wave + (C.lane >> 4) * 4 + r) * 128 + 16 * nt + (C.lane & 15)] = acc[nt][r];
    }
    __syncthreads();
}
__device__ __forceinline__ void ret_prefix(Ctx& C, int l) {
    for (int i = C.gtid; i < NB * NH * 4096; i += C.gthreads) { const int bh = i >> 12, e = (i & 4095) * 4, h = bh & 7;
        const float gc = expf((float)RC * ret_logg(h)); f32x4 run = (f32x4){0.f, 0.f, 0.f, 0.f};
        float* p = cKV + (size_t)bh * NCH * 16384 + e;
#pragma unroll 1
        for (int jb = 0; jb < NCH; jb += 8) { f32x4 t[8];
#pragma unroll
            for (int j = 0; j < 8; ++j) t[j] = *(const f32x4*)(p + (size_t)(jb + j) * 16384);
#pragma unroll
            for (int j = 0; j < 8; ++j) { *(f32x4*)(p + (size_t)(jb + j) * 16384) = run; run = gc * run + t[j]; } }
        *(f32x4*)(C.out + O_RETP + (size_t)(l * NB * NH + bh) * 16384 + e) = run; }
}
__device__ __forceinline__ void ret_pass2(Ctx& C, int l) {
    const float* in26 = INP(26);
    LAS bf16_t* QS = (LAS bf16_t*)C.lds; LAS bf16_t* KS = QS + 128 * TP; LAS bf16_t* VT = KS + 128 * TP; LAS bf16_t* RT = VT + 128 * TP;
    for (int it = C.vcu; it < NB * NH * NCH; it += C.G) {
        const int j = it & 15, bh = it >> 4, h = bh & 7, b = bh >> 3; const size_t row0 = (size_t)b * SEQ + j * RC;
        const float lg = ret_logg(h);
        __syncthreads();
        { const int tok = C.tid >> 2, qd = C.tid & 3; float a1[16], a2[16];
          rope_load(C, row0 + tok, C_Q + h * 128, j * RC + tok, qd, a1, a2);
#pragma unroll
          for (int i = 0; i < 2; ++i) { u32x4 w, w2;
#pragma unroll
              for (int k = 0; k < 4; ++k) { w[k] = pk2(a1[8 * i + 2 * k], a1[8 * i + 2 * k + 1]); w2[k] = pk2(a2[8 * i + 2 * k], a2[8 * i + 2 * k + 1]); }
              *(LAS u32x4*)(QS + tok * TP + 16 * qd + 8 * i) = w; *(LAS u32x4*)(QS + tok * TP + 64 + 16 * qd + 8 * i) = w2; }
          rope_load(C, row0 + tok, C_K + h * 128, j * RC + tok, qd, a1, a2);
          const float sc = 0.08838834764831845f;
#pragma unroll
          for (int i = 0; i < 2; ++i) { u32x4 w, w2;
#pragma unroll
              for (int k = 0; k < 4; ++k) { w[k] = pk2(a1[8 * i + 2 * k] * sc, a1[8 * i + 2 * k + 1] * sc); w2[k] = pk2(a2[8 * i + 2 * k] * sc, a2[8 * i + 2 * k + 1] * sc); }
              *(LAS u32x4*)(KS + tok * TP + 16 * qd + 8 * i) = w; *(LAS u32x4*)(KS + tok * TP + 64 + 16 * qd + 8 * i) = w2; } }
        load_vt(C, VT, row0, h);
        { const int d = C.tid >> 2, eq = C.tid & 3; const float* src = cKV + (size_t)it * 16384 + d * 128 + 32 * eq;
#pragma unroll
          for (int k = 0; k < 8; ++k) { const f32x4 v = *(const f32x4*)(src + 4 * k);
#pragma unroll
              for (int i = 0; i < 4; ++i) RT[(32 * eq + 4 * k + i) * TP + d] = (bf16_t)f2bf(v[i]); } }
        __syncthreads();
        const int ib = 16 * C.wave + (C.lane >> 4) * 4, jc = C.lane & 15;
        f32x4 acc[8], s[8];
#pragma unroll
        for (int nt = 0; nt < 8; ++nt) { acc[nt] = (f32x4){0.f, 0.f, 0.f, 0.f}; s[nt] = (f32x4){0.f, 0.f, 0.f, 0.f}; }
        wave_mma_128(QS, 16 * C.wave, RT, acc, C.lane);
#pragma unroll
        for (int r = 0; r < 4; ++r) { const float xi = __expf((float)(ib + r + 1) * lg);
#pragma unroll
            for (int nt = 0; nt < 8; ++nt) acc[nt][r] *= xi; }
        wave_mma_128(QS, 16 * C.wave, KS, s, C.lane);
        __syncthreads();
        { float gi[4], gj[8];
#pragma unroll
          for (int r = 0; r < 4; ++r) gi[r] = __expf((float)((C.lane >> 4) * 4 + r) * lg);
#pragma unroll
          for (int nt = 0; nt < 8; ++nt) gj[nt] = __expf((float)(16 * C.wave - 16 * nt - jc) * lg);
#pragma unroll
          for (int nt = 0; nt < 8; ++nt)
#pragma unroll
              for (int r = 0; r < 4; ++r) { const int i = ib + r, jj = 16 * nt + jc; const float dm = (i >= jj) ? gi[r] * gj[nt] : 0.f;
                  KS[i * TP + jj] = (bf16_t)f2bf(s[nt][r] * dm); } }
        LDS_WAIT(); asm volatile("" ::: "memory");
        wave_mma_128(KS, 16 * C.wave, VT, acc, C.lane);
#pragma unroll
        for (int r = 0; r < 4; ++r) { float s1 = 0.f;
#pragma unroll
            for (int nt = 0; nt < 8; ++nt) s1 += acc[nt][r];
            s1 += __shfl_xor(s1, 1); s1 += __shfl_xor(s1, 2); s1 += __shfl_xor(s1, 4); s1 += __shfl_xor(s1, 8);
            const float mu = s1 * (1.0f / 128.0f); float s2 = 0.f;
#pragma unroll
            for (int nt = 0; nt < 8; ++nt) { const float dlt = acc[nt][r] - mu; s2 += dlt * dlt; }
            s2 += __shfl_xor(s2, 1); s2 += __shfl_xor(s2, 2); s2 += __shfl_xor(s2, 4); s2 += __shfl_xor(s2, 8);
            const float rstd = 1.0f / sqrtf(s2 * (1.0f / 128.0f) + GN_EPS);
#pragma unroll
            for (int nt = 0; nt < 8; ++nt) QS[(ib + r) * TP + 16 * nt + jc] = (bf16_t)f2bf((acc[nt][r] - mu) * rstd); }
        LDS_WAIT(); asm volatile("" ::: "memory");
#pragma unroll
        for (int i = 0; i < 4; ++i) { const int cidx = C.lane + 64 * i, tr = cidx >> 4, c8 = (cidx & 15) * 8; const size_t row = row0 + 16 * C.wave + tr;
            const u32x4 ov = *(const LAS u32x4*)(QS + (16 * C.wave + tr) * TP + c8), zv = *(const u32x4*)(cPROJ + row * NIN + C_ZRET + h * 128 + c8);
            const f32x4 g0 = *(const f32x4*)(in26 + l * 1024 + h * 128 + c8), g1 = *(const f32x4*)(in26 + l * 1024 + h * 128 + c8 + 4); const float gg[8] = {g0[0], g0[1], g0[2], g0[3], g1[0], g1[1], g1[2], g1[3]};
            u32x4 w;
#pragma unroll
            for (int j = 0; j < 4; ++j) w[j] = pk2(bflo(ov[j]) * gg[2 * j] * siluf_(bflo(zv[j])), bfhi(ov[j]) * gg[2 * j + 1] * siluf_(bfhi(zv[j])));
            *(u32x4*)(cARET + row * 1024 + h * 128 + c8) = w; }
    }
    __syncthreads();
}
__device__ __forceinline__ void ret_sample(Ctx& C, int l) {
    const float* in6 = INP(6); const float* in26 = INP(26);
    LAS float* qs = (LAS float*)C.lds; LAS float* ks = qs + 1024; LAS float* vs = ks + 1024; LAS float* SM = vs + 1024; LAS float* OP = SM + 64;
    for (int it = C.vcu; it < DB * NH; it += C.G) {
        const int h = it & 7, bs = it >> 3; const size_t row0 = (size_t)MP + bs * DS; const float lg = ret_logg(h);
        const float* rin = in6 + ((size_t)(l * DB + bs) * NH + h) * 16384; float* rout = C.out + O_RETS + ((size_t)(l * DB + bs) * NH + h) * 16384;
        const int e4 = (C.tid & 31) * 4, d0 = (C.tid >> 5) * 8;
        f32x4 r[8];
#pragma unroll
        for (int dd = 0; dd < 8; ++dd) r[dd] = *(const f32x4*)(rin + (d0 + dd) * 128 + e4);
        __syncthreads();
        { const int tok = C.tid >> 6, x = C.tid & 63; const bf16_t* pr = cPROJ + (row0 + tok) * NIN + h * 128;
          const float c = cROPE[(size_t)(2048 + tok) * 64 + x], sn = cROPE[(size_t)2056 * 64 + (size_t)(2048 + tok) * 64 + x];
          const float q1 = bf2f(pr[C_Q + x]), q2 = bf2f(pr[C_Q + 64 + x]), k1 = bf2f(pr[C_K + x]), k2 = bf2f(pr[C_K + 64 + x]);
          qs[tok * 128 + x] = q1 * c - q2 * sn; qs[tok * 128 + 64 + x] = q1 * sn + q2 * c;
          ks[tok * 128 + x] = (k1 * c - k2 * sn) * 0.08838834764831845f; ks[tok * 128 + 64 + x] = (k1 * sn + k2 * c) * 0.08838834764831845f;
          vs[tok * 128 + x] = bf2f(pr[C_V + x]); vs[tok * 128 + 64 + x] = bf2f(pr[C_V + 64 + x]); }
        __syncthreads();
        { const int ij = C.tid >> 3, part = C.tid & 7, i = ij >> 3, jj = ij & 7; float a = 0.f;
#pragma unroll
          for (int dq = 0; dq < 4; ++dq) { const f32x4 qa = *(const LAS f32x4*)(qs + i * 128 + part * 16 + 4 * dq), kb = *(const LAS f32x4*)(ks + jj * 128 + part * 16 + 4 * dq); a += (qa[0] * kb[0] + qa[1] * kb[1]) + (qa[2] * kb[2] + qa[3] * kb[3]); }
          a += __shfl_xor(a, 1); a += __shfl_xor(a, 2); a += __shfl_xor(a, 4);
          if (part == 0) SM[ij] = a; }
        { f32x4 v4[8], oacc[8]; float gz[8]; const float g8 = expf(8.0f * lg);
#pragma unroll
          for (int t = 0; t < 8; ++t) { v4[t] = *(const LAS f32x4*)(vs + t * 128 + e4); oacc[t] = (f32x4){0.f, 0.f, 0.f, 0.f}; gz[t] = expf((float)(7 - t) * lg); }
#pragma unroll
          for (int dd = 0; dd < 8; ++dd) { const int d = d0 + dd; f32x4 rn = g8 * r[dd];
#pragma unroll
              for (int t = 0; t < 8; ++t) { oacc[t] += qs[t * 128 + d] * r[dd]; rn += (gz[t] * ks[t * 128 + d]) * v4[t]; }
              *(f32x4*)(rout + d * 128 + e4) = rn; }
#pragma unroll
          for (int t = 0; t < 8; ++t) {
#pragma unroll
              for (int k = 0; k < 4; ++k) oacc[t][k] += __shfl_xor(oacc[t][k], 32);
              if (C.lane < 32) *(LAS f32x4*)(OP + (C.wave * 8 + t) * 128 + e4) = oacc[t]; } }
        __syncthreads();
        { const int tok = C.tid >> 6, x = C.tid & 63; float o[2];
#pragma unroll
          for (int hh = 0; hh < 2; ++hh) { const int e = x + 64 * hh; float a = 0.f;
#pragma unroll
              for (int w = 0; w < 8; ++w) a += OP[(w * 8 + tok) * 128 + e];
              a *= expf((float)(tok + 1) * lg);
              for (int jj = 0; jj <= tok; ++jj) a += expf((float)(tok - jj) * lg) * SM[tok * 8 + jj] * vs[jj * 128 + e];
              o[hh] = a; }
          const float mu = wave_sum(o[0] + o[1]) * (1.0f / 128.0f); const float dd0 = o[0] - mu, dd1 = o[1] - mu;
          const float rstd = 1.0f / sqrtf(wave_sum(dd0 * dd0 + dd1 * dd1) * (1.0f / 128.0f) + GN_EPS);
          const bf16_t* pr = cPROJ + (row0 + tok) * NIN + C_ZRET + h * 128; bf16_t* dst = cARET + (row0 + tok) * 1024 + h * 128; const float* gn = in26 + l * 1024 + h * 128;
          dst[x] = (bf16_t)f2bf(dd0 * rstd * gn[x] * siluf_(bf2f(pr[x]))); dst[x + 64] = (bf16_t)f2bf(dd1 * rstd * gn[x + 64] * siluf_(bf2f(pr[x + 64]))); }
    }
    __syncthreads();
}

__device__ __forceinline__ void phase_final(Ctx& C) {
    const float* in31 = INP(31);
    for (int m = C.gw; m < M; m += C.ngw) { float ss = 0.f;
        if (C.lane < 32) ss = cRSP[(size_t)m * 32 + C.lane];
        ss = wave_sum(ss); const float rs = 1.0f / sqrtf(ss * (1.0f / DM) + NORM_EPS);
        float* xr = C.out + (size_t)m * DM;
#pragma unroll
        for (int j = 0; j < 8; ++j) { const int c = 4 * C.lane + 256 * j; const f32x4 v = *(const f32x4*)(xr + c), g = *(const f32x4*)(in31 + c); *(f32x4*)(xr + c) = v * rs * g; } }
}


#define XB_TMO      128
#define XB_XCNT(j)  (256  + 64 * (j))
#define XB_XSUB(j)  (1280 + 64 * (j))
#define XB_XGEN(j)  (2304 + 64 * (j))
#define XB_TOP      3328
#define XB_TOPGEN   3392
#define XCD_BAR_WORDS 3456
#define XB_SPIN_CAP (1u << 20)
__device__ __forceinline__ unsigned xb_ld(unsigned* p)              { return __hip_atomic_load(p, __ATOMIC_RELAXED, __HIP_MEMORY_SCOPE_AGENT); }
__device__ __forceinline__ unsigned xb_add(unsigned* p, unsigned v) { return __hip_atomic_fetch_add(p, v, __ATOMIC_RELAXED, __HIP_MEMORY_SCOPE_AGENT); }
__device__ __forceinline__ unsigned xb_xcc_id() { return (unsigned)__builtin_amdgcn_s_getreg((3 << 11) | 20) & 0xFu; }
#define XB_SPIN(cond, bar) do { unsigned _sp = 0; while (cond) { __builtin_amdgcn_s_sleep(1); \
    if ((++_sp & 255u) == 0u) { if (xb_ld(&(bar)[XB_TMO])) break; if (_sp > XB_SPIN_CAP) { atomicAdd(&(bar)[XB_TMO], 1u); break; } } } } while (0)
struct XcdBarrier { unsigned* bar; unsigned x; volatile LAS unsigned* st; };
__device__ __forceinline__ XcdBarrier xcd_barrier_post(unsigned* bar, volatile LAS unsigned* st) {
    XcdBarrier b; b.bar = bar; b.x = xb_xcc_id(); b.st = st;
    if (threadIdx.x == 0) (void)xb_add(&bar[XB_XCNT(b.x)], 1u);
    return b;
}
__device__ __forceinline__ void xcd_barrier_complete(unsigned* bar, unsigned x, unsigned& nloc, unsigned& nx) {
    const unsigned G = gridDim.x * gridDim.y * gridDim.z;
    unsigned sum, cnt, mine, sp = 0u;
    for (;;) {
        sum = 0u; cnt = 0u; mine = 0u;
#pragma unroll 1
        for (unsigned j = 0; j < 16; ++j) { const unsigned c = xb_ld(&bar[XB_XCNT(j)]); sum += c; cnt += (c > 0u) ? 1u : 0u; mine = (j == x) ? c : mine; }
        if (sum == G) break;
        __builtin_amdgcn_s_sleep(1);
        if ((++sp & 255u) == 0u) { if (xb_ld(&bar[XB_TMO])) break; if (sp > XB_SPIN_CAP) { atomicAdd(&bar[XB_TMO], 1u); break; } }
    }
    nloc = mine > 0u ? mine : 1u; nx = cnt > 0u ? cnt : 1u;
}
__device__ __forceinline__ void xcd_barrier(const XcdBarrier& b) {
    asm volatile("s_waitcnt vmcnt(0)" ::: "memory");
    __syncthreads();
    int t0 = (int)threadIdx.x; asm volatile("" : "+v"(t0));
    if (t0 == 0) {
        unsigned long long bp = (unsigned long long)b.bar; asm volatile("" : "+s"(bp)); unsigned* bar = (unsigned*)bp;
        __builtin_amdgcn_s_waitcnt(0);
        unsigned nloc = b.st[0], nx = b.st[1];
        if (nloc == 0u) { xcd_barrier_complete(bar, b.x, nloc, nx); b.st[0] = nloc; b.st[1] = nx; }
        const unsigned old = xb_add(&bar[XB_XSUB(b.x)], 1u);
        const unsigned gen = old / nloc;
        if (old + 1u == (gen + 1u) * nloc) {
            __builtin_amdgcn_fence(__ATOMIC_RELEASE, "agent");
            asm volatile("s_waitcnt vmcnt(0)" ::: "memory");
            const unsigned og = xb_add(&bar[XB_TOP], 1u);
            const unsigned tg = og / nx;
            if (og + 1u == (tg + 1u) * nx) xb_add(&bar[XB_TOPGEN], 1u);
            else XB_SPIN(xb_ld(&bar[XB_TOPGEN]) == tg, bar);
            __builtin_amdgcn_fence(__ATOMIC_ACQUIRE, "agent");
            xb_add(&bar[XB_XGEN(b.x)], 1u);
            asm volatile("s_waitcnt vmcnt(0)" ::: "memory");
        } else {
            XB_SPIN(xb_ld(&bar[XB_XGEN(b.x)]) == gen, bar);
            __builtin_amdgcn_fence(__ATOMIC_ACQUIRE, "agent");
            asm volatile("s_waitcnt vmcnt(0)" ::: "memory");
        }
    }
    __syncthreads();
}

constexpr int PH_PER_LAYER = 8, N_PHASES = 2 * PH_PER_LAYER + 1;
#define PHASE_BEGIN() \
    int bid = (int)blockIdx.x, tidv = (int)threadIdx.x, gdim = (int)gridDim.x; asm volatile("" : "+s"(bid), "+v"(tidv), "+s"(gdim)); \
    C.tid = tidv; C.lane = C.tid & 63; C.wave = __builtin_amdgcn_readfirstlane(C.tid >> 6); \
    C.G = gdim; C.vcu = (C.G % 8 == 0) ? (bid % 8) * (C.G / 8) + bid / 8 : bid; \
    C.gtid = C.vcu * NTHR + C.tid; C.gthreads = C.G * NTHR; C.gw = C.vcu * NWAVES + C.wave; C.ngw = C.G * NWAVES; \
    { unsigned long long w_ = (unsigned long long)args.ws, o_ = (unsigned long long)args.out; asm volatile("" : "+s"(w_), "+s"(o_)); C.ws = (unsigned char*)w_; C.out = (float*)o_; }
#define PHASE_END(ph) do { if ((ph) + 1 < hi) { if ((ph) == lo) cg::this_grid().sync(); else xcd_barrier(xbar); } } while (0)
#define IN_RANGE(ph) (lo <= (ph) && (ph) < hi)

template <int l>
__device__ __forceinline__ void layer_phases(Ctx& C, const Args& args, const XcdBarrier& xbar, const int lo, const int hi) {
    constexpr int P0 = l * PH_PER_LAYER;
    if (IN_RANGE(P0 + 0)) { PHASE_BEGIN(); (void)bid; phase_prep(C, l); PHASE_END(P0 + 0); }
    if (IN_RANGE(P0 + 1)) { PHASE_BEGIN(); pg8::Gemm g{}; g.A = cXB; g.Bt = cWIN; g.K = DM; pg8::StaticOrder<1> S; S.init(M, NIN, C.G, bid);
        pg8::EpiProj E{cPROJ, cRS}; pg8::gemm_phase<pg8::EpiProj>(C.lds, C.tid, g, S, E); PHASE_END(P0 + 1); }
    if (IN_RANGE(P0 + 2)) { PHASE_BEGIN(); (void)bid; s5_pass1(C, l); lru_tiles(C, l); ret_pass1(C); ret_sample(C, l); PHASE_END(P0 + 2); }
    if (IN_RANGE(P0 + 3)) { PHASE_BEGIN(); (void)bid; s5_carry(C, l); lru_carry(C, l); ret_prefix(C, l); if (l == 0) convert_win(C, 1); PHASE_END(P0 + 3); }
    if (IN_RANGE(P0 + 4)) { PHASE_BEGIN(); (void)bid; s5_pass2(C, l); lru_fin(C); ret_pass2(C, l); PHASE_END(P0 + 4); }
    if (IN_RANGE(P0 + 5)) { PHASE_BEGIN(); pg8::Gemm g{}; g.A = cYS5; g.Bt = cWGLU; g.K = 1024; pg8::StaticOrder<1> S; S.init(M, 1024, C.G, bid);
        pg8::EpiGlu E{cAS5, cYS5, cPROJ, INP(18) + l * 1024}; pg8::gemm_phase<pg8::EpiGlu>(C.lds, C.tid, g, S, E); PHASE_END(P0 + 5); }
    if (IN_RANGE(P0 + 6)) { PHASE_BEGIN(); pg8::Gemm g{}; g.A = cAS5; g.Bt = cWBR; g.zA = WS_ALRU - WS_AS5; g.zB = (size_t)DM * 1024 * 2; g.K = 1024;
        pg8::StaticOrder<3> S; S.init(M, DM, C.G, bid);
        pg8::EpiMerge E{cMERGED, cPROJ}; pg8::gemm_phase<pg8::EpiMerge, 3>(C.lds, C.tid, g, S, E); PHASE_END(P0 + 6); }
    if (IN_RANGE(P0 + 7)) { PHASE_BEGIN(); pg8::Gemm g{}; g.A = cMERGED; g.Bt = cWOUT; g.K = DM; pg8::StaticOrder<1> S; S.init(M, DM, C.G, bid);
        const float* x0 = INP(0); const float* x1 = INP(1);
        pg8::EpiOut E{l == 0 ? x0 : C.out, l == 0 ? x1 : C.out + (size_t)MP * DM, C.out, l == 0 ? cXB : (bf16_t*)nullptr, cRSP}; pg8::gemm_phase<pg8::EpiOut>(C.lds, C.tid, g, S, E); PHASE_END(P0 + 7); }
}

__global__ void __launch_bounds__(NTHR, 2) fwd_kernel(Args args) {
    extern __shared__ __attribute__((aligned(16))) unsigned char lds_raw[];
    Ctx C;
    C.lds = (LAS unsigned char*)lds_raw;
    C.in = args.in;
    { volatile LAS unsigned* misc = (volatile LAS unsigned*)(C.lds + LDS_MISC_OFF); if (threadIdx.x < 32) misc[threadIdx.x] = 0u; }
    __syncthreads();
    XcdBarrier xbar = xcd_barrier_post((unsigned*)(args.ws + WS_CTL) + 4096, (volatile LAS unsigned*)(C.lds + LDS_MISC_OFF) + 8);
    const int lo = args.ph_lo, hi = args.ph_hi;
    layer_phases<0>(C, args, xbar, lo, hi);
    layer_phases<1>(C, args, xbar, lo, hi);
    if (IN_RANGE(N_PHASES - 1)) { PHASE_BEGIN(); (void)bid; phase_final(C); }
}

#ifdef PROBE_TABLE
__global__ void probe_kernel(float* out) {
    const float tab[12][2] = PROBE_TABLE;
    const size_t offs[13] = {O_YP, O_YS, O_S5RP, O_S5IP, O_LRUP, O_CONVP, O_RETP, O_S5RS, O_S5IS, O_LRUS, O_CONVS, O_RETS, O_END};
    for (int o = 0; o < 12; ++o) { const size_t n = offs[o + 1] - offs[o], half = n / 2;
        for (size_t i = (size_t)blockIdx.x * blockDim.x + threadIdx.x; i < n; i += (size_t)gridDim.x * blockDim.x) { const float s = (o < 2) ? tab[o][0] : tab[o][i >= half];
            out[offs[o] + i] = (s == 0.f) ? 0.f : out[offs[o] + i] * s; } }
}
#endif

extern "C" void kernel_launch(void* const* d_in, const int* in_sizes, int n_in, void* d_out, int out_size, void* d_ws, size_t ws_size, hipStream_t stream) {
    static int grid = 0;
    if (grid == 0) {
        if (n_in != 32 || out_size != (int)O_END || ws_size < WS_END) { fprintf(stderr, "kernel_launch: unexpected shapes: n_in %d out %d ws %zu (need %zu)\n", n_in, out_size, ws_size, (size_t)WS_END); grid = -1; return; }
        int dev = 0, cus = 0, per_cu = 0;
        if (hipGetDevice(&dev) != hipSuccess || hipDeviceGetAttribute(&cus, hipDeviceAttributeMultiprocessorCount, dev) != hipSuccess) { grid = -1; return; }
        if (hipFuncSetAttribute((const void*)fwd_kernel, hipFuncAttributeMaxDynamicSharedMemorySize, LDS_BYTES) != hipSuccess) { fprintf(stderr, "kernel_launch: hipFuncSetAttribute failed\n"); grid = -1; return; }
        if (hipOccupancyMaxActiveBlocksPerMultiprocessor(&per_cu, (const void*)fwd_kernel, NTHR, LDS_BYTES) != hipSuccess || per_cu < 1) { fprintf(stderr, "kernel_launch: occupancy query says %d\n", per_cu); per_cu = 1; }
        (void)hipGetLastError();
        grid = cus;
    }
    if (grid < 0) return;
    (void)hipMemsetAsync((char*)d_ws + WS_CTL, 0, CTL_ZERO_BYTES, stream);
    Args a{};
    for (int i = 0; i < 32; ++i) a.in[i] = (const float*)d_in[i];
    a.out = (float*)d_out; a.ws = (unsigned char*)d_ws;
#if MK_N_LAUNCHES == 1
    a.ph_lo = 0; a.ph_hi = N_PHASES;
    void* kargs[] = {&a};
    hipError_t e = hipLaunchCooperativeKernel((const void*)fwd_kernel, dim3(grid), dim3(NTHR), kargs, LDS_BYTES, stream);
    if (e != hipSuccess) fprintf(stderr, "kernel_launch: cooperative launch failed: %s (grid %d)\n", hipGetErrorString(e), grid);
#else
    for (int ph = 0; ph < N_PHASES; ++ph) { a.ph_lo = ph; a.ph_hi = ph + 1; hipLaunchKernelGGL(fwd_kernel, dim3(grid), dim3(NTHR), LDS_BYTES, stream, a); }
#endif
#ifdef PROBE_TABLE
    hipLaunchKernelGGL(probe_kernel, dim3(2048), dim3(256), 0, stream, (float*)d_out);
#endif
}
```
